# Optimizing an MI355X kernel written in HIP

```python
import jax, jax.numpy as jnp
from jax import lax
import numpy as np

D_MODEL = 1024
BATCH = 8
SEQ = 4096
DEPTH = 4

GRID_W = 64
CTX_LEN = 256
EPS = 1e-6

HEAD_DIM = 64
ATT_HEADS = 8
ATT_KV_HEADS = 2
ATT_GROUP = ATT_HEADS // ATT_KV_HEADS
WINDOW = 128
ATT_BLOCK = 128
ROPE_BASE = 10000.0
ATT_DIM = ATT_HEADS * HEAD_DIM
KV_DIM = ATT_KV_HEADS * HEAD_DIM

POOL_WINDOWS = (2, 4, 8, 16)
POOL_GROUPS = len(POOL_WINDOWS)
POOL_GROUP_DIM = 64
POOL_DIM = POOL_GROUPS * POOL_GROUP_DIM

GLA_HEADS = 4
GLA_DK = 32
GLA_DV = 64
GLA_GATE_RANK = 16
GLA_TAU = 16.0
GLA_CHUNK = 64
GLA_QK_DIM = GLA_HEADS * GLA_DK
GLA_V_DIM = GLA_HEADS * GLA_DV

N_BRANCH = 3

SPLITS = (ATT_DIM, KV_DIM, KV_DIM, POOL_DIM, GLA_QK_DIM, GLA_QK_DIM, GLA_V_DIM,
          GLA_V_DIM, 2 * GLA_GATE_RANK, N_BRANCH * D_MODEL)
SPLIT_IDX = tuple(int(s) for s in np.cumsum(SPLITS)[:-1])
IN_DIM = int(sum(SPLITS))

D_FF = 2816
CONV_W = 3

kernel_name = "hybrid_gated_branch_flow_block"

F32 = jnp.float32


def rmsnorm(x, g):
    xf = x.astype(F32)
    y = xf * lax.rsqrt(jnp.mean(xf * xf, axis=-1, keepdims=True) + EPS)
    return (y * g.astype(F32)).astype(x.dtype)


def axial_rope_tables(L):
    rows = L // GRID_W
    row = jnp.repeat(jnp.arange(rows, dtype=F32), GRID_W)
    col = jnp.tile(jnp.arange(GRID_W, dtype=F32), rows)
    n = HEAD_DIM // 4
    inv = ROPE_BASE ** (-jnp.arange(n, dtype=F32) / n)
    ang = jnp.concatenate([row[:, None] * inv, col[:, None] * inv], axis=-1)
    return jnp.cos(ang), jnp.sin(ang)


def apply_rope(x, cos, sin):
    xf = x.astype(F32)
    half = HEAD_DIM // 2
    x1, x2 = xf[..., :half], xf[..., half:]
    c = cos[None, :, None, :]
    s = sin[None, :, None, :]
    return jnp.concatenate([x1 * c - x2 * s, x1 * s + x2 * c], axis=-1).astype(x.dtype)


def window_attention(q, k, v, k_ctx, v_ctx, sink):
    B, L = q.shape[:2]
    C = k_ctx.shape[1]
    nb = L // ATT_BLOCK
    scale = HEAD_DIM ** -0.5
    qb = q.reshape(B, nb, ATT_BLOCK, ATT_KV_HEADS, ATT_GROUP, HEAD_DIM)
    pad = ((0, 0), (ATT_BLOCK, ATT_BLOCK), (0, 0), (0, 0))
    kp = jnp.pad(k, pad).reshape(B, nb + 2, ATT_BLOCK, ATT_KV_HEADS, HEAD_DIM)
    vp = jnp.pad(v, pad).reshape(B, nb + 2, ATT_BLOCK, ATT_KV_HEADS, HEAD_DIM)
    kw = jnp.concatenate([kp[:, :-2], kp[:, 1:-1], kp[:, 2:]], axis=2)
    vw = jnp.concatenate([vp[:, :-2], vp[:, 1:-1], vp[:, 2:]], axis=2)
    s_loc = jnp.einsum('bnqkgd,bnskd->bnkgqs', qb, kw, preferred_element_type=F32) * scale
    s_ctx = jnp.einsum('bnqkgd,bckd->bnkgqc', qb, k_ctx, preferred_element_type=F32) * scale
    qi = jnp.arange(ATT_BLOCK)[:, None]
    kj = jnp.arange(3 * ATT_BLOCK)[None, :]
    band = jnp.abs(kj - ATT_BLOCK - qi) <= WINDOW
    kpos = jnp.arange(nb)[:, None] * ATT_BLOCK - ATT_BLOCK + jnp.arange(3 * ATT_BLOCK)[None, :]
    valid = (kpos >= 0) & (kpos < L)
    mask = band[None, :, :] & valid[:, None, :]
    s_loc = jnp.where(mask[None, :, None, None], s_loc, -jnp.inf)
    sk = jnp.broadcast_to(sink.astype(F32).reshape(ATT_KV_HEADS, ATT_GROUP)[:, :, None, None],
                          s_loc.shape[:-1] + (1,))
    p = jax.nn.softmax(jnp.concatenate([s_loc, s_ctx, sk], axis=-1), axis=-1)
    nl = 3 * ATT_BLOCK
    p_loc = p[..., :nl].astype(v.dtype)
    p_ctx = p[..., nl:nl + C].astype(v.dtype)
    o = (jnp.einsum('bnkgqs,bnskd->bnqkgd', p_loc, vw)
         + jnp.einsum('bnkgqc,bckd->bnqkgd', p_ctx, v_ctx))
    return o.reshape(B, L, ATT_DIM)


def ctx_attention(q, k, v, sink):
    B, C = q.shape[:2]
    qg = q.reshape(B, C, ATT_KV_HEADS, ATT_GROUP, HEAD_DIM)
    s = jnp.einsum('bqkgd,bskd->bkgqs', qg, k, preferred_element_type=F32) * (HEAD_DIM ** -0.5)
    sk = jnp.broadcast_to(sink.astype(F32).reshape(ATT_KV_HEADS, ATT_GROUP)[:, :, None, None],
                          s.shape[:-1] + (1,))
    p = jax.nn.softmax(jnp.concatenate([s, sk], axis=-1), axis=-1)[..., :C].astype(v.dtype)
    return jnp.einsum('bkgqs,bskd->bqkgd', p, v).reshape(B, C, ATT_DIM)


def multiscale_pool(u):
    T = u.shape[1]
    uf = u.astype(F32)
    cs = jnp.pad(jnp.cumsum(uf, axis=1), ((0, 0), (1, 0), (0, 0)))
    t = jnp.arange(T)
    outs = []
    for g, w in enumerate(POOL_WINDOWS):
        lo = w // 2
        hi = w - lo - 1
        start = jnp.clip(t - lo, 0, T)
        end = jnp.clip(t + hi + 1, 0, T)
        sl = slice(g * POOL_GROUP_DIM, (g + 1) * POOL_GROUP_DIM)
        csg = cs[..., sl]
        cnt = (end - start).astype(F32)
        outs.append((csg[:, end] - csg[:, start]) / cnt[None, :, None] - uf[..., sl])
    return jnp.concatenate(outs, axis=-1)


def pool_branch(u, pool_w, pool_scale):
    B, T, _ = u.shape
    d = multiscale_pool(u).astype(u.dtype).reshape(B, T, POOL_GROUPS, POOL_GROUP_DIM)
    y = jnp.einsum('btgi,gio->btgo', d, pool_w).reshape(B, T, POOL_DIM)
    return y * pool_scale


def gla_inputs(gq, gk, gv, glr, gla_wa2, gla_ba):
    B, T = gq.shape[:2]
    q = gq.reshape(B, T, GLA_HEADS, GLA_DK) * (GLA_DK ** -0.5)
    k = gk.reshape(B, T, GLA_HEADS, GLA_DK)
    v = gv.reshape(B, T, GLA_HEADS, GLA_DV)
    lr = glr.astype(F32).reshape(B, T, 2, GLA_GATE_RANK)
    z = jnp.einsum('btnr,nrd->btnd', lr, gla_wa2.astype(F32)) + gla_ba.astype(F32)
    log_a = jax.nn.log_sigmoid(z) / GLA_TAU
    la_f = log_a[:, :, 0].reshape(B, T, GLA_HEADS, GLA_DK)
    la_b = log_a[:, :, 1].reshape(B, T, GLA_HEADS, GLA_DK)
    return q, k, v, la_f, la_b


def gla_scan(q, k, v, log_a, state0):
    B, T = q.shape[:2]
    n = T // GLA_CHUNK

    def to_chunks(t):
        return t.reshape(B, n, GLA_CHUNK, GLA_HEADS, -1).transpose(1, 0, 3, 2, 4).astype(F32)

    tri = jnp.tril(jnp.ones((GLA_CHUNK, GLA_CHUNK), dtype=bool))

    def step(S, inp):
        qi, ki, vi, ai = inp
        b = jnp.cumsum(ai, axis=2)
        b_last = b[:, :, -1:, :]
        o_inter = jnp.einsum('bhcd,bhde->bhce', qi * jnp.exp(b), S)
        diff = b[:, :, :, None, :] - b[:, :, None, :, :]
        decay = jnp.exp(jnp.where(tri[:, :, None], diff, -jnp.inf))
        att = jnp.einsum('bhid,bhjd,bhijd->bhij', qi, ki, decay)
        o = o_inter + jnp.einsum('bhij,bhje->bhie', att, vi)
        S_new = (S * jnp.exp(b_last[:, :, 0, :])[..., None]
                 + jnp.einsum('bhcd,bhce->bhde', ki * jnp.exp(b_last - b), vi))
        return S_new, o

    S_fin, o = lax.scan(step, state0, (to_chunks(q), to_chunks(k), to_chunks(v), to_chunks(log_a)))
    o = o.transpose(1, 0, 3, 2, 4).reshape(B, T, GLA_HEADS, GLA_DV)
    return o, S_fin


def flip(t):
    return t[:, ::-1]


def gla_output(o, r, gla_norm):
    B, T = o.shape[:2]
    on = o * lax.rsqrt(jnp.mean(o * o, axis=-1, keepdims=True) + EPS) * gla_norm.astype(F32)
    return on.reshape(B, T, GLA_V_DIM).astype(r.dtype) * jax.nn.silu(r)


def merge_branches(y_att, y_pool, y_gla, mg, w_br_att, w_br_pool, w_br_gla, w_o):
    B, T = y_att.shape[:2]
    g = jax.nn.sigmoid(mg).reshape(B, T, N_BRANCH, D_MODEL)
    m = (g[:, :, 0] * (y_att @ w_br_att) + g[:, :, 1] * (y_pool @ w_br_pool)
         + g[:, :, 2] * (y_gla @ w_br_gla))
    return m @ w_o


def token_mixer(h, hc, need_ctx, w_in, att_sink, pool_w, pool_scale, gla_wa2, gla_ba, gla_norm,
                w_br_att, w_br_pool, w_br_gla, w_o):
    B, L, _ = h.shape
    C = hc.shape[1]
    aq, ak, av, pu, gq, gk, gv, gr, glr, mg = jnp.split(h @ w_in, SPLIT_IDX, axis=-1)
    caq, cak, cav, cpu, cgq, cgk, cgv, cgr, cglr, cmg = jnp.split(hc @ w_in, SPLIT_IDX, axis=-1)

    k_ctx = cak.reshape(B, C, ATT_KV_HEADS, HEAD_DIM)
    v_ctx = cav.reshape(B, C, ATT_KV_HEADS, HEAD_DIM)
    cos, sin = axial_rope_tables(L)
    q = apply_rope(aq.reshape(B, L, ATT_HEADS, HEAD_DIM), cos, sin)
    k = apply_rope(ak.reshape(B, L, ATT_KV_HEADS, HEAD_DIM), cos, sin)
    v = av.reshape(B, L, ATT_KV_HEADS, HEAD_DIM)
    y_att = window_attention(q, k, v, k_ctx, v_ctx, att_sink)

    y_pool = pool_branch(pu, pool_w, pool_scale)

    lq, lk, lv, la_f, la_b = gla_inputs(gq, gk, gv, glr, gla_wa2, gla_ba)
    xq, xk, xv, xa_f, xa_b = gla_inputs(cgq, cgk, cgv, cglr, gla_wa2, gla_ba)
    S0 = jnp.zeros((B, GLA_HEADS, GLA_DK, GLA_DV), F32)
    co_f, S_f = gla_scan(xq, xk, xv, xa_f, S0)
    co_b, S_b = gla_scan(flip(xq), flip(xk), flip(xv), flip(xa_b), S0)
    o_f, _ = gla_scan(lq, lk, lv, la_f, S_f)
    o_b, _ = gla_scan(flip(lq), flip(lk), flip(lv), flip(la_b), S_b)
    y_gla = gla_output(o_f + flip(o_b), gr, gla_norm)

    y = merge_branches(y_att, y_pool, y_gla, mg, w_br_att, w_br_pool, w_br_gla, w_o)
    if not need_ctx:
        return y, None
    yc_att = ctx_attention(caq.reshape(B, C, ATT_HEADS, HEAD_DIM), k_ctx, v_ctx, att_sink)
    yc_pool = pool_branch(cpu, pool_w, pool_scale)
    yc_gla = gla_output(co_f + flip(co_b), cgr, gla_norm)
    yc = merge_branches(yc_att, yc_pool, yc_gla, cmg, w_br_att, w_br_pool, w_br_gla, w_o)
    return y, yc


def conv_ffn(h, w_up, conv_w, conv_b, w_down):
    u = h @ w_up
    up = jnp.pad(u, ((0, 0), (1, 1), (0, 0)))
    u = up[:, :-2] * conv_w[0] + up[:, 1:-1] * conv_w[1] + up[:, 2:] * conv_w[2] + conv_b
    a, g = jnp.split(u, 2, axis=-1)
    return (a * jax.nn.silu(g)) @ w_down


def setup_inputs(seed: int = 0) -> dict:
    key = jax.random.key(seed)
    ks = jax.random.split(key, 28)

    def nrm(k, shape, scale):
        return jax.random.normal(k, shape, F32) * scale

    return {
        "x": nrm(ks[0], (BATCH, SEQ, D_MODEL), 1.0),
        "c": nrm(ks[1], (BATCH, D_MODEL), 1.0),
        "ctx": nrm(ks[2], (BATCH, CTX_LEN, D_MODEL), 1.0),
        "c_ctx": nrm(ks[3], (D_MODEL,), 1.0),
        "w_ada": nrm(ks[4], (DEPTH, D_MODEL, 6 * D_MODEL), 0.5 * D_MODEL ** -0.5),
        "b_ada": nrm(ks[5], (DEPTH, 6 * D_MODEL), 0.01),
        "g_pre_mix": 1.0 + nrm(ks[6], (DEPTH, D_MODEL), 0.02),
        "g_post_mix": 1.0 + nrm(ks[7], (DEPTH, D_MODEL), 0.02),
        "g_pre_ffn": 1.0 + nrm(ks[8], (DEPTH, D_MODEL), 0.02),
        "g_post_ffn": 1.0 + nrm(ks[9], (DEPTH, D_MODEL), 0.02),
        "w_in": nrm(ks[10], (DEPTH, D_MODEL, IN_DIM), D_MODEL ** -0.5),
        "att_sink": nrm(ks[11], (DEPTH, ATT_HEADS), 0.5),
        "pool_w": nrm(ks[12], (DEPTH, POOL_GROUPS, POOL_GROUP_DIM, POOL_GROUP_DIM), POOL_GROUP_DIM ** -0.5),
        "pool_scale": 1.0 + nrm(ks[13], (DEPTH, POOL_DIM), 0.02),
        "gla_wa2": nrm(ks[14], (DEPTH, 2, GLA_GATE_RANK, GLA_QK_DIM), GLA_GATE_RANK ** -0.5),
        "gla_ba": 1.0 + nrm(ks[15], (DEPTH, 2, GLA_QK_DIM), 0.1),
        "gla_norm": 1.0 + nrm(ks[16], (DEPTH, GLA_HEADS, GLA_DV), 0.02),
        "w_br_att": nrm(ks[17], (DEPTH, ATT_DIM, D_MODEL), ATT_DIM ** -0.5),
        "w_br_pool": nrm(ks[18], (DEPTH, POOL_DIM, D_MODEL), POOL_DIM ** -0.5),
        "w_br_gla": nrm(ks[19], (DEPTH, GLA_V_DIM, D_MODEL), GLA_V_DIM ** -0.5),
        "w_o": nrm(ks[20], (DEPTH, D_MODEL, D_MODEL), D_MODEL ** -0.5),
        "w_up": nrm(ks[21], (DEPTH, D_MODEL, 2 * D_FF), D_MODEL ** -0.5),
        "conv_w": nrm(ks[22], (DEPTH, CONV_W, 2 * D_FF), CONV_W ** -0.5),
        "conv_b": nrm(ks[23], (DEPTH, 2 * D_FF), 0.01),
        "w_down": nrm(ks[24], (DEPTH, D_FF, D_MODEL), D_FF ** -0.5),
    }


def reference(x, c, ctx, c_ctx, w_ada, b_ada, g_pre_mix, g_post_mix, g_pre_ffn, g_post_ffn,
              w_in, att_sink, pool_w, pool_scale, gla_wa2, gla_ba, gla_norm,
              w_br_att, w_br_pool, w_br_gla, w_o, w_up, conv_w, conv_b, w_down):
    for l in range(DEPTH):
        last = l == DEPTH - 1
        m = jax.nn.silu(c) @ w_ada[l] + b_ada[l]
        mc = jax.nn.silu(c_ctx) @ w_ada[l] + b_ada[l]
        sh1, sc1, g1, sh2, sc2, g2 = jnp.split(m[:, None, :], 6, axis=-1)
        csh1, csc1, cg1, csh2, csc2, cg2 = jnp.split(mc, 6)

        h = rmsnorm(x, g_pre_mix[l]) * (1.0 + sc1) + sh1
        hc = rmsnorm(ctx, g_pre_mix[l]) * (1.0 + csc1) + csh1
        y, yc = token_mixer(h, hc, not last, w_in[l], att_sink[l], pool_w[l], pool_scale[l],
                            gla_wa2[l], gla_ba[l], gla_norm[l], w_br_att[l], w_br_pool[l],
                            w_br_gla[l], w_o[l])
        x = x + g1 * rmsnorm(y, g_post_mix[l])
        h = rmsnorm(x, g_pre_ffn[l]) * (1.0 + sc2) + sh2
        x = x + g2 * rmsnorm(conv_ffn(h, w_up[l], conv_w[l], conv_b[l], w_down[l]), g_post_ffn[l])

        if not last:
            ctx = ctx + cg1 * rmsnorm(yc, g_post_mix[l])
            hc = rmsnorm(ctx, g_pre_ffn[l]) * (1.0 + csc2) + csh2
            ctx = ctx + cg2 * rmsnorm(conv_ffn(hc, w_up[l], conv_w[l], conv_b[l], w_down[l]), g_post_ffn[l])
    return x
```

```cpp
#include <hip/hip_runtime.h>
#include <hip/hip_cooperative_groups.h>
#include <cstdio>
namespace cg = cooperative_groups;

#ifndef DIS_GEMM
#define EN_GEMM(...) __VA_ARGS__
#else
#define EN_GEMM(...)
#endif
#ifndef DIS_ADA
#define EN_ADA(...) __VA_ARGS__
#else
#define EN_ADA(...)
#endif
#ifndef DIS_CVT
#define EN_CVT(...) __VA_ARGS__
#else
#define EN_CVT(...)
#endif
#ifndef DIS_ROW
#define EN_ROW(...) __VA_ARGS__
#else
#define EN_ROW(...)
#endif
#ifndef DIS_G1
#define EN_G1(...) __VA_ARGS__
#else
#define EN_G1(...)
#endif
#ifndef DIS_ATT
#define EN_ATT(...) __VA_ARGS__
#else
#define EN_ATT(...)
#endif
#ifndef DIS_GLA1
#define EN_GLA1(...) __VA_ARGS__
#else
#define EN_GLA1(...)
#endif
#ifndef DIS_POOL
#define EN_POOL(...) __VA_ARGS__
#else
#define EN_POOL(...)
#endif
#ifndef DIS_SCAN
#define EN_SCAN(...) __VA_ARGS__
#else
#define EN_SCAN(...)
#endif
#ifndef DIS_GLA3
#define EN_GLA3(...) __VA_ARGS__
#else
#define EN_GLA3(...)
#endif
#ifndef DIS_GM
#define EN_GM(...) __VA_ARGS__
#else
#define EN_GM(...)
#endif
#ifndef DIS_GO
#define EN_GO(...) __VA_ARGS__
#else
#define EN_GO(...)
#endif
#ifndef DIS_GU
#define EN_GU(...) __VA_ARGS__
#else
#define EN_GU(...)
#endif
#ifndef DIS_CONV
#define EN_CONV(...) __VA_ARGS__
#else
#define EN_CONV(...)
#endif
#ifndef DIS_GD
#define EN_GD(...) __VA_ARGS__
#else
#define EN_GD(...)
#endif
#define LAS __attribute__((address_space(3)))
#define DI __device__ __forceinline__
typedef unsigned short bf16_t;
typedef short bf16x8 __attribute__((ext_vector_type(8)));
typedef short s16x4 __attribute__((ext_vector_type(4)));
typedef float f32x4 __attribute__((ext_vector_type(4)));
typedef float f32x2 __attribute__((ext_vector_type(2)));
typedef unsigned u32x4 __attribute__((ext_vector_type(4)));
typedef unsigned u32x2 __attribute__((ext_vector_type(2)));

constexpr int DM = 1024, NB = 8, SEQ = 4096, DEPTH = 4, CTXL = 256;
constexpr int ML = NB * SEQ, MC = NB * CTXL, MT = ML + MC;
constexpr int IN_DIM = 4896, IN_PAD = 5120, DFF = 2816, UPN = 5632;
constexpr int C_AQ = 0, C_AK = 512, C_AV = 640, C_PU = 768, C_GQ = 1024, C_GK = 1152, C_GV = 1280, C_GR = 1536, C_GLR = 1792, C_MG = 1824;
constexpr int NCH = MT / 64;
constexpr float EPS = 1e-6f;
constexpr int NTHR = 512;
constexpr int LDS_BYTES = 131072 + 64 + 8192 + 4096;

constexpr size_t WS_CTXRES = 0;
constexpr size_t WS_MOD = WS_CTXRES + (size_t)MC * DM * 4;
constexpr size_t WS_ROPE = WS_MOD + (size_t)DEPTH * 9 * 6144 * 4;
constexpr size_t WS_GDEC = WS_ROPE + 64 * 16 * 2 * 4;
constexpr size_t WS_WIN = WS_GDEC + (size_t)NCH * 4 * 2 * 32 * 4;
constexpr size_t WS_WBR = WS_WIN + (size_t)IN_PAD * 1024 * 2;
constexpr size_t WS_WO = WS_WBR + (size_t)3072 * 512 * 2;
constexpr size_t WS_WUP = WS_WO + (size_t)1024 * 1024 * 2;
constexpr size_t WS_WDN = WS_WUP + (size_t)UPN * 1024 * 2;
constexpr size_t WS_H = WS_WDN + (size_t)1024 * DFF * 2;
constexpr size_t WS_M2 = WS_H + (size_t)MT * 1024 * 2;
constexpr size_t WS_P = WS_M2 + (size_t)MT * 1024 * 2;
constexpr size_t WS_BAR = WS_P + (size_t)MT * IN_DIM * 2;
constexpr size_t WS_END = WS_BAR + 16384;
constexpr size_t PO_ACT = 0;
constexpr size_t PO_UCH = (size_t)MT * DFF * 2;
constexpr size_t PO_Y2 = PO_UCH;
static_assert(PO_Y2 + (size_t)MT * 1024 * 4 <= (size_t)MT * IN_DIM * 2, "P region too small");
static_assert(PO_UCH + (size_t)10240 * UPN * 2 <= (size_t)MT * IN_DIM * 2, "P region too small");

struct Params { const float* in[25]; float* out; unsigned char* ws; int ph_lo, ph_hi; };
typedef const float* const volatile __attribute__((address_space(4))) * KargTbl;
#define PIN(i) (((KargTbl)__builtin_amdgcn_kernarg_segment_ptr())[i])

DI float bf2f(bf16_t b) { return __uint_as_float(((unsigned)b) << 16); }
DI bf16_t f2bf(float f) { unsigned u = __float_as_uint(f); u += 0x7FFFu + ((u >> 16) & 1u); return (bf16_t)(u >> 16); }
typedef __bf16 bf16x2v __attribute__((ext_vector_type(2)));
DI unsigned pk_bf16(float lo, float hi) { const f32x2 v = {lo, hi}; return __builtin_bit_cast(unsigned, __builtin_convertvector(v, bf16x2v)); }
DI float lo_f(unsigned w) { return __uint_as_float(w << 16); }
DI float hi_f(unsigned w) { return __uint_as_float(w & 0xffff0000u); }
DI float sigmoidf_(float x) { return __builtin_amdgcn_rcpf(1.f + __expf(-x)); }
DI float siluf_(float x) { return x * __builtin_amdgcn_rcpf(1.f + __expf(-x)); }
DI int obid() { int t = blockIdx.x; asm volatile("" : "+s"(t)); return t; }
DI int ogrid() { int t = gridDim.x; asm volatile("" : "+s"(t)); return t; }
DI int otid() { int t = threadIdx.x; asm volatile("" : "+v"(t)); return t; }
DI float shx(float v, int m, int lane) { return __int_as_float(__builtin_amdgcn_ds_bpermute((lane ^ m) << 2, __float_as_int(v))); }
DI float wave_sum(float v) {
    const int lane = otid() & 63;
#pragma unroll
    for (int o = 32; o >= 1; o >>= 1) v += shx(v, o, lane);
    return v;
}

namespace pg8 {
constexpr int BM = 256, BK = 64, HALF = 128, HTB = HALF * BK * 2, STAGE_BYTES = 8 * HTB, NXCD = 8, WGM = 8;
DI int lds_byte(int r, int c) { const int st = (r >> 4) * 2 + (c >> 5), rr = r & 15, cc = c & 31, ob = rr * 64 + cc * 2; return st * 1024 + (ob ^ (((ob >> 9) & 1) << 5)); }
DI void stage_rc(int b, int& R, int& C) { const int st = b / 1024, sb = b % 1024, swz = sb ^ (((sb >> 9) & 1) << 5); R = (st >> 1) * 16 + swz / 64; C = (st & 1) * 32 + (swz % 64) / 2; }
DI int perm32(int rho) { const int n = rho >> 4, i = rho & 15; return 8 * (i >> 2) + 4 * n + (i & 3); }
struct Unit { int pm, pn; };
struct Gemm { const bf16_t* A; const bf16_t* Bt; int M, N, K, lda, ldb, asplit, aoff2; };
struct StaticOrder {
    int nM, nN, nwg, G, c;
    DI void init(int M, int N, int G_, int c_) { nM = M / BM; nN = N / BM; nwg = nM * nN; G = G_; c = c_; }
    DI bool next(int i, Unit& u) const {
        const long L = (long)i * G + c; if (L >= nwg) return false;
        int wgid = (int)L; { const int q = nwg / NXCD, r = nwg % NXCD, xcd = wgid % NXCD, off = wgid / NXCD; wgid = (xcd < r ? xcd * (q + 1) : r * (q + 1) + (xcd - r) * q) + off; }
        const int nig = WGM * nN, gid = wgid / nig, fm = gid * WGM, gsz = (nM - fm) < WGM ? (nM - fm) : WGM;
        u.pm = fm + ((wgid % nig) % gsz); u.pn = (wgid % nig) / gsz; return true;
    }
};

template <class Epi>
DI void gemm_phase(LAS unsigned char* lds, const Gemm g, const StaticOrder& S, const Epi& E) {
    const int tid = otid(), wid = __builtin_amdgcn_readfirstlane(tid >> 6), lane = tid & 63, wr = wid >> 2, wc = wid & 3, fr = lane & 15, fq = lane >> 4;
    const int K = g.K, nt = K / BK;
    unsigned voffA[2], voffB[2];
#pragma unroll
    for (int i = 0; i < 2; ++i) { int R, C; stage_rc(tid * 16 + i * 8192, R, C); const int Rb = Epi::PERM ? ((R & ~31) + perm32(R & 31)) : R;
        voffA[i] = (unsigned)(R * g.lda + C) * 2u; voffB[i] = (unsigned)(Rb * g.ldb + C) * 2u; }
    const size_t kstep = (size_t)(BK * 2);
    const size_t hstepA = (size_t)HALF * g.lda * 2, hstepB = (size_t)HALF * g.ldb * 2;
    const size_t tstepA = 2 * hstepA, tstepB = 2 * hstepB;
    const unsigned ldsw = (unsigned)wid * 1024u;
    const int aoff = lds_byte(wr * 64 + fr, fq * 8), boff = lds_byte(wc * 32 + fr, fq * 8);
#define PG8_SA(b, h) (((b) * 2 + (h)) * HTB)
#define PG8_SB(b, h) ((4 + (b) * 2 + (h)) * HTB)
#define PG8_STAGE(bufoff, gbase, voff) do { _Pragma("unroll") for (int _i = 0; _i < 2; ++_i) \
        __builtin_amdgcn_global_load_lds((const unsigned*)((const char*)(gbase) + (voff)[_i]), (LAS unsigned*)(lds + (bufoff) + ldsw + _i * 8192), 16, 0, 0); } while (0)
#define PG8_LDA(dst, b, h) do { _Pragma("unroll") for (int m = 0; m < 4; ++m) _Pragma("unroll") for (int k = 0; k < 2; ++k) dst[m][k] = *(const LAS bf16x8*)(lds + PG8_SA(b, h) + aoff + m * 2048 + k * 1024); } while (0)
#define PG8_LDB(dst, b, h) do { _Pragma("unroll") for (int n = 0; n < 2; ++n) _Pragma("unroll") for (int k = 0; k < 2; ++k) dst[n][k] = *(const LAS bf16x8*)(lds + PG8_SB(b, h) + boff + n * 2048 + k * 1024); } while (0)
#define PG8_MMA(ai, bj, At, Bt) do { __builtin_amdgcn_s_setprio(1); _Pragma("unroll") for (int m = 0; m < 4; ++m) _Pragma("unroll") for (int n = 0; n < 2; ++n) _Pragma("unroll") for (int k = 0; k < 2; ++k) \
        acc[ai][bj][m][n] = __builtin_amdgcn_mfma_f32_16x16x32_bf16(Bt[n][k], At[m][k], acc[ai][bj][m][n], 0, 0, 0); __builtin_amdgcn_s_setprio(0); } while (0)
#define PG8_WAIT_V(n) asm volatile("s_waitcnt vmcnt(" #n ")" ::: "memory")
#define PG8_WAIT_L(n) asm volatile("s_waitcnt lgkmcnt(" #n ")" ::: "memory")
#define PG8_BAR __builtin_amdgcn_s_barrier()
#define PG8_SCHED __builtin_amdgcn_sched_barrier(0)
    Unit cur, nxt; int ui = 0;
    if (!S.next(0, cur)) return;
    f32x4 acc[2][2][4][2];
#pragma unroll
    for (int a = 0; a < 2; ++a)
#pragma unroll
        for (int b = 0; b < 2; ++b)
#pragma unroll
            for (int m = 0; m < 4; ++m)
#pragma unroll
                for (int n = 0; n < 2; ++n) acc[a][b][m][n] = (f32x4){0.f, 0.f, 0.f, 0.f};
    bf16x8 At[4][2], B0[2][2], B1[2][2];
    const bool mrg = (g.asplit == 4);
#define PG8_AOFS(u) (mrg ? ((u).pn >= 8 ? 1536 : ((u).pn >= 4 ? 1024 : 0)) : 0)
#define PG8_BOFS(u) ((mrg && (u).pn >= 8) ? 512 : 0)
#define PG8_NT(u) ((mrg && (u).pn >= 4) ? 4 : nt)
    const char* cA = (const char*)g.A + (size_t)cur.pm * tstepA + PG8_AOFS(cur); const char* cB = (const char*)g.Bt + (size_t)cur.pn * tstepB + PG8_BOFS(cur);
    PG8_STAGE(PG8_SB(0, 0), cB, voffB); PG8_STAGE(PG8_SA(0, 0), cA, voffA); PG8_STAGE(PG8_SB(0, 1), cB + hstepB, voffB); PG8_STAGE(PG8_SA(0, 1), cA + hstepA, voffA);
    if (wr == 1) PG8_BAR;
    PG8_WAIT_V(4); PG8_BAR;
    PG8_STAGE(PG8_SB(1, 0), cB + kstep, voffB); PG8_STAGE(PG8_SA(1, 0), cA + kstep, voffA); PG8_STAGE(PG8_SB(1, 1), cB + hstepB + kstep, voffB);
    PG8_WAIT_V(6); PG8_BAR;
    for (;;) {
        const bool has_next = S.next(ui + 1, nxt);
        const char* nA = has_next ? (const char*)g.A + (size_t)nxt.pm * tstepA + PG8_AOFS(nxt) : cA; const char* nB = has_next ? (const char*)g.Bt + (size_t)nxt.pn * tstepB + PG8_BOFS(nxt) : cB;
        const int ntc = PG8_NT(cur);
        for (int t = 0; t < ntc; t += 2) {
            const bool last = (t == ntc - 2);
            const char* a1 = cA + (size_t)(t + 1) * kstep;
            const char* a2 = last ? nA : cA + (size_t)(t + 2) * kstep; const char* b2 = last ? nB : cB + (size_t)(t + 2) * kstep;
            const char* a3 = a2 + kstep; const char* b3 = b2 + kstep;
            PG8_LDB(B0, 0, 0); PG8_SCHED; PG8_LDA(At, 0, 0); PG8_STAGE(PG8_SA(1, 1), a1 + hstepA, voffA);
            PG8_WAIT_L(8); PG8_BAR; PG8_WAIT_L(0); PG8_MMA(0, 0, At, B0); PG8_BAR; PG8_SCHED;
            PG8_LDB(B1, 0, 1); PG8_STAGE(PG8_SB(0, 0), b2, voffB);
            PG8_BAR; PG8_WAIT_L(0); PG8_MMA(0, 1, At, B1); PG8_BAR;
            PG8_LDA(At, 0, 1); PG8_STAGE(PG8_SA(0, 0), a2, voffA);
            PG8_BAR; PG8_WAIT_L(0); PG8_MMA(1, 0, At, B0); PG8_BAR; PG8_SCHED;
            PG8_STAGE(PG8_SB(0, 1), b2 + hstepB, voffB);
            PG8_WAIT_V(6); PG8_BAR; PG8_MMA(1, 1, At, B1); PG8_BAR;
            PG8_LDB(B0, 1, 0); PG8_SCHED; PG8_LDA(At, 1, 0); PG8_STAGE(PG8_SA(0, 1), a2 + hstepA, voffA);
            PG8_WAIT_L(8); PG8_BAR; PG8_WAIT_L(0); PG8_MMA(0, 0, At, B0); PG8_BAR; PG8_SCHED;
            PG8_LDB(B1, 1, 1); PG8_STAGE(PG8_SB(1, 0), b3, voffB);
            PG8_BAR; PG8_WAIT_L(0); PG8_MMA(0, 1, At, B1); PG8_BAR;
            PG8_LDA(At, 1, 1); PG8_STAGE(PG8_SA(1, 0), a3, voffA);
            PG8_BAR; PG8_WAIT_L(0); PG8_MMA(1, 0, At, B0); PG8_BAR; PG8_SCHED;
            PG8_STAGE(PG8_SB(1, 1), b3 + hstepB, voffB);
            PG8_WAIT_V(6); PG8_BAR; PG8_MMA(1, 1, At, B1); PG8_BAR;
        }
        {
            int wr2 = wr, wc2 = wc; Unit cu2 = cur; Epi E2 = E;
            asm volatile("" : "+s"(wr2), "+s"(wc2), "+s"(cu2.pm), "+s"(cu2.pn), "+s"(E2.ws), "+s"(E2.aux));
            const int ln2 = otid() & 63;
            const int fr2 = ln2 & 15, fq2 = ln2 >> 4;
            E2(acc, cu2, wr2, wc2, fr2, fq2, lds);
        }
        if (!has_next) break;
#pragma unroll
        for (int a = 0; a < 2; ++a)
#pragma unroll
            for (int b = 0; b < 2; ++b)
#pragma unroll
                for (int m = 0; m < 4; ++m)
#pragma unroll
                    for (int n = 0; n < 2; ++n) acc[a][b][m][n] = (f32x4){0.f, 0.f, 0.f, 0.f};
        cur = nxt; cA = nA; cB = nB; ++ui;
    }
    PG8_WAIT_V(0);
    if (wr == 0) PG8_BAR;
    PG8_BAR;
#undef PG8_AOFS
#undef PG8_BOFS
#undef PG8_NT
#undef PG8_SA
#undef PG8_SB
#undef PG8_STAGE
#undef PG8_LDA
#undef PG8_LDB
#undef PG8_MMA
#undef PG8_WAIT_V
#undef PG8_WAIT_L
#undef PG8_BAR
#undef PG8_SCHED
}

struct EpiU {
    static constexpr bool PERM = true;
    int mode; int aux; unsigned char* ws;
    DI void operator()(const f32x4 (&acc)[2][2][4][2], const Unit& u, int wr, int wc, int fr, int fq, LAS unsigned char* lds) const {
        void* const out = (mode == 0) ? (void*)(ws + WS_P) : (mode == 1) ? (void*)(ws + WS_P + (aux ? PO_Y2 : 0)) : (mode == 2) ? (void*)(ws + WS_M2) : (void*)(ws + WS_P + PO_ACT);
        const int ldc = (mode == 0) ? IN_DIM : 1024, ncols = IN_DIM, br = aux;
        const bf16_t* const P = (const bf16_t*)(ws + WS_P);
        const float* const cw = PIN(22) + (size_t)aux * 3 * UPN; const float* const cb = PIN(23) + (size_t)aux * UPN;
        float* const edge = (float*)(ws + WS_P + PO_UCH);
        const int row0 = u.pm * BM + wr * 64 + fr, col0 = u.pn * BM + wc * 32 + 8 * fq;
        const unsigned rl0 = (unsigned)(wr * 64 + fr), cl0 = (unsigned)(wc * 32 + 8 * fq);
        if (mode == 0) {
            bf16_t* Ob = (bf16_t*)out + (size_t)u.pm * BM * ldc + u.pn * BM;
#pragma unroll
            for (int ai = 0; ai < 2; ++ai)
#pragma unroll
                for (int m = 0; m < 4; ++m)
#pragma unroll
                    for (int bj = 0; bj < 2; ++bj) { const int col = col0 + bj * HALF;
                        const f32x4 v0 = acc[ai][bj][m][0], v1 = acc[ai][bj][m][1];
                        u32x4 o; o[0] = pk_bf16(v0[0], v0[1]); o[1] = pk_bf16(v0[2], v0[3]); o[2] = pk_bf16(v1[0], v1[1]); o[3] = pk_bf16(v1[2], v1[3]);
                        if (col < ncols) *(u32x4*)(Ob + ((rl0 + ai * HALF + m * 16) * (unsigned)IN_DIM + cl0 + bj * HALF)) = o; }
        } else if (mode == 1) {
            float* Cb = (float*)out + (size_t)u.pm * BM * 1024 + u.pn * BM;
#pragma unroll
            for (int ai = 0; ai < 2; ++ai)
#pragma unroll
                for (int m = 0; m < 4; ++m)
#pragma unroll
                    for (int bj = 0; bj < 2; ++bj) { float* rp = Cb + ((rl0 + ai * HALF + m * 16) * 1024u + cl0 + bj * HALF);
                        *(f32x4*)rp = acc[ai][bj][m][0]; *(f32x4*)(rp + 4) = acc[ai][bj][m][1]; }
        } else if (mode == 3) {
            bf16_t* ACTb = (bf16_t*)out + (size_t)u.pm * 256 * DFF + u.pn * 128;
            LAS float* XR = (LAS float*)(lds + 131072 + 64);
            LAS float* CWL = XR + 2048;
            const int lane = (fq << 4) | fr;
            const int cl = wc * 32 + 8 * fq;
            if (fr == 0) {
#pragma unroll
                for (int ai = 0; ai < 2; ++ai)
#pragma unroll
                    for (int bj = 0; bj < 2; ++bj)
#pragma unroll
                        for (int n = 0; n < 2; ++n) *(LAS f32x4*)(XR + ((((wr * 2 + ai) * 2 + 0) * 2 + bj) * 128 + cl + 4 * n)) = acc[ai][bj][0][n];
            }
            if (fr == 15) {
#pragma unroll
                for (int ai = 0; ai < 2; ++ai)
#pragma unroll
                    for (int bj = 0; bj < 2; ++bj)
#pragma unroll
                        for (int n = 0; n < 2; ++n) *(LAS f32x4*)(XR + ((((wr * 2 + ai) * 2 + 1) * 2 + bj) * 128 + cl + 4 * n)) = acc[ai][bj][3][n];
            }
            {
                float* EGb = edge + (size_t)u.pm * 4 * UPN + u.pn * 256;
                if (wr == 0 && fr < 2) {
#pragma unroll
                    for (int bj = 0; bj < 2; ++bj)
#pragma unroll
                        for (int n = 0; n < 2; ++n) *(f32x4*)(EGb + (unsigned)(fr * UPN + cl + bj * 128 + 4 * n)) = acc[0][bj][0][n];
                }
                if (wr == 1 && fr >= 14) {
#pragma unroll
                    for (int bj = 0; bj < 2; ++bj)
#pragma unroll
                        for (int n = 0; n < 2; ++n) *(f32x4*)(EGb + (unsigned)((fr - 12) * UPN + cl + bj * 128 + 4 * n)) = acc[1][bj][3][n];
                }
            }
            {
                const int tid = (((wr << 2) | wc) << 6) | lane;
#pragma unroll
                for (int i = 0; i < 2; ++i) {
                    const int idx = tid + 512 * i, pp = idx >> 7, c = idx & 127;
                    const int srcc = ((pp >= 4) ? DFF : 0) + u.pn * 128 + c;
                    CWL[idx] = ((pp & 3) == 3) ? cb[srcc] : cw[(pp & 3) * UPN + srcc];
                }
            }
            asm volatile("s_waitcnt vmcnt(0) lgkmcnt(0)" ::: "memory");
            __builtin_amdgcn_s_barrier(); __builtin_amdgcn_s_barrier();
            asm volatile("" ::: "memory");
#pragma unroll
            for (int ai = 0; ai < 2; ++ai) {
                const bool hasp = !(wr == 0 && ai == 0), hasn = !(wr == 1 && ai == 1);
                const int pw = (wr == 1) ? 0 : 1, pa = (wr == 1) ? ai : 0;
                const int nw = (wr == 0) ? 1 : 0, na = (wr == 0) ? ai : 1;
                const LAS float* xp = XR + ((((pw * 2 + pa) * 2 + 1) * 2 + 0) * 128 + cl);
                const LAS float* xn = XR + ((((nw * 2 + na) * 2 + 0) * 2 + 0) * 128 + cl);
#pragma unroll
                for (int n = 0; n < 2; ++n) {
                    float o[4][4];
#pragma unroll
                    for (int e = 0; e < 4; ++e) {
                        const LAS float* cwp = CWL + cl + 4 * n + e;
                        const float xpa = hasp ? xp[4 * n + e] : 0.f, xpg = hasp ? xp[128 + 4 * n + e] : 0.f;
                        const float xna = hasn ? xn[4 * n + e] : 0.f, xng = hasn ? xn[128 + 4 * n + e] : 0.f;
                        float ap[4], gp[4], an[4], gn[4];
#pragma unroll
                        for (int m = 0; m < 4; ++m) {
                            const float ca = acc[ai][0][m][n][e], cg2 = acc[ai][1][m][n][e];
                            const float oa_p = (fr == 15) ? acc[ai][0][m == 0 ? 0 : m - 1][n][e] : ca, og_p = (fr == 15) ? acc[ai][1][m == 0 ? 0 : m - 1][n][e] : cg2;
                            const float oa_n = (fr == 0) ? acc[ai][0][m == 3 ? 3 : m + 1][n][e] : ca, og_n = (fr == 0) ? acc[ai][1][m == 3 ? 3 : m + 1][n][e] : cg2;
                            ap[m] = __int_as_float(__builtin_amdgcn_mov_dpp(__float_as_int(oa_p), 0x121, 0xF, 0xF, false));
                            gp[m] = __int_as_float(__builtin_amdgcn_mov_dpp(__float_as_int(og_p), 0x121, 0xF, 0xF, false));
                            an[m] = __int_as_float(__builtin_amdgcn_mov_dpp(__float_as_int(oa_n), 0x12F, 0xF, 0xF, false));
                            gn[m] = __int_as_float(__builtin_amdgcn_mov_dpp(__float_as_int(og_n), 0x12F, 0xF, 0xF, false));
                        }
                        ap[0] = (fr == 0) ? xpa : ap[0]; gp[0] = (fr == 0) ? xpg : gp[0];
                        an[3] = (fr == 15) ? xna : an[3]; gn[3] = (fr == 15) ? xng : gn[3];
                        const float w0a = cwp[0], w1a = cwp[128], w2a = cwp[256], bba = cwp[384];
                        const float w0g = cwp[512], w1g = cwp[640], w2g = cwp[768], bbg = cwp[896];
#pragma unroll
                        for (int m = 0; m < 4; ++m) {
                            const float av = w0a * ap[m] + w1a * acc[ai][0][m][n][e] + w2a * an[m] + bba;
                            const float gv = w0g * gp[m] + w1g * acc[ai][1][m][n][e] + w2g * gn[m] + bbg;
                            o[m][e] = av * siluf_(gv);
                        }
                        __builtin_amdgcn_sched_barrier(0);
                    }
#pragma unroll
                    for (int m = 0; m < 4; ++m) {
                        u32x2 ov; ov[0] = pk_bf16(o[m][0], o[m][1]); ov[1] = pk_bf16(o[m][2], o[m][3]);
                        *(u32x2*)(ACTb + (unsigned)((wr * 64 + fr + ai * HALF + m * 16) * DFF + cl + 4 * n)) = ov;
                    }
                    __builtin_amdgcn_sched_barrier(0);
                }
            }
        } else {
            bf16_t* Gb = (bf16_t*)(ws + WS_P) + C_MG + (size_t)u.pm * BM * IN_DIM + u.pn * BM;
#pragma unroll
            for (int ai = 0; ai < 2; ++ai)
#pragma unroll
                for (int m = 0; m < 4; ++m)
#pragma unroll
                    for (int bj = 0; bj < 2; ++bj) {
                        bf16_t* gp = Gb + ((rl0 + ai * HALF + m * 16) * (unsigned)IN_DIM + cl0 + bj * HALF);
                        const u32x4 gv = *(const u32x4*)gp;
                        const f32x4 v0 = acc[ai][bj][m][0], v1 = acc[ai][bj][m][1];
                        u32x4 o;
                        o[0] = pk_bf16(v0[0] * sigmoidf_(lo_f(gv[0])), v0[1] * sigmoidf_(hi_f(gv[0]))); o[1] = pk_bf16(v0[2] * sigmoidf_(lo_f(gv[1])), v0[3] * sigmoidf_(hi_f(gv[1])));
                        o[2] = pk_bf16(v1[0] * sigmoidf_(lo_f(gv[2])), v1[1] * sigmoidf_(hi_f(gv[2]))); o[3] = pk_bf16(v1[2] * sigmoidf_(lo_f(gv[3])), v1[3] * sigmoidf_(hi_f(gv[3])));
                        *(u32x4*)gp = o; }
        }
    }
};
}

template <class Epi>
DI void run_gemm(unsigned char* lds, const bf16_t* A, int lda, const bf16_t* Bt, int ldb, int M, int N, int K, const Epi& E, int asplit = 1 << 30, int aoff2 = 0) {
    pg8::Gemm g{A, Bt, M, N, K, lda, ldb, asplit, aoff2};
    pg8::StaticOrder S; S.init(M, N, ogrid(), obid());
    pg8::gemm_phase<Epi>((LAS unsigned char*)lds, g, S, E);
}

DI void sincos_acc(float x, float& c, float& s) {
    const double xd = (double)x;
    const double kd = __builtin_rint(xd * 0.63661977236758134308);
    double r = __builtin_fma(-kd, 1.57079632679489655800, xd);
    r = __builtin_fma(-kd, 6.12323399573676603587e-17, r);
    const double r2 = r * r;
    const double sp = r * (1.0 + r2 * (-1.0 / 6 + r2 * (1.0 / 120 + r2 * (-1.0 / 5040 + r2 * (1.0 / 362880 + r2 * (-1.0 / 39916800 + r2 * (1.0 / 6227020800.0)))))));
    const double cp = 1.0 + r2 * (-0.5 + r2 * (1.0 / 24 + r2 * (-1.0 / 720 + r2 * (1.0 / 40320 + r2 * (-1.0 / 3628800 + r2 * (1.0 / 479001600.0 + r2 * (-1.0 / 87178291200.0)))))));
    const int k = ((int)kd) & 3;
    const double cc = (k == 0) ? cp : (k == 1) ? -sp : (k == 2) ? -cp : sp;
    const double ss = (k == 0) ? sp : (k == 1) ? cp : (k == 2) ? -sp : -cp;
    c = (float)cc; s = (float)ss;
}

DI void phase_rope(unsigned char* ws) {
    const int tid = otid();
    {
        float* rt = (float*)(ws + WS_ROPE);
        for (int i = tid; i < 1024; i += NTHR) {
            const int pos = i >> 4, fi = i & 15;
            const double b4 = ((fi & 3) == 0) ? 1.0 : ((fi & 3) == 1) ? 0.56234132519034908 : ((fi & 3) == 2) ? 0.31622776601683794 : 0.17782794100389228;
            const double p10 = ((fi >> 2) == 0) ? 1.0 : ((fi >> 2) == 1) ? 0.1 : ((fi >> 2) == 2) ? 0.01 : 0.001;
            const float inv = (float)(b4 * p10);
            const float ang = (float)pos * inv;
            float c, s; sincos_acc(ang, c, s);
            rt[2 * i] = c; rt[2 * i + 1] = s;
        }
    }
}

DI const float* p_wada(const float* w_ada, int l) { return w_ada + (size_t)l * 1024 * 6144; }
DI void phase_ada(const float* c_in, const float* cctx_in, const float* w_ada, const float* b_ada, unsigned char* ws, unsigned char* lds) {
    float* sc = (float*)lds;
    float* red = sc + 9 * 1024;
    const int tid = otid();
    float* modt = (float*)(ws + WS_MOD);
    for (int i = tid; i < 9 * 1024; i += NTHR) { const int r = i >> 10, k = i & 1023; const float v = r < 8 ? c_in[r * 1024 + k] : cctx_in[k]; sc[i] = siluf_(v); }
    __syncthreads();
    for (int it = obid(); it < DEPTH * 48; it += ogrid()) {
        const int l = it / 48, cgp = it % 48;
        const int c4 = (tid & 31) * 4, kg = tid >> 5;
        const float* W = p_wada(w_ada, l) + cgp * 128 + c4;
        float acc[9][4];
#pragma unroll
        for (int r = 0; r < 9; ++r)
#pragma unroll
            for (int j = 0; j < 4; ++j) acc[r][j] = 0.f;
#pragma unroll 8
        for (int k = kg * 64; k < kg * 64 + 64; ++k) {
            const f32x4 w = __builtin_nontemporal_load((const f32x4*)(W + (size_t)k * 6144));
#pragma unroll
            for (int r = 0; r < 9; ++r) { const float sv = sc[r * 1024 + k]; acc[r][0] += sv * w[0]; acc[r][1] += sv * w[1]; acc[r][2] += sv * w[2]; acc[r][3] += sv * w[3]; }
        }
#pragma unroll
        for (int r = 0; r < 9; ++r)
#pragma unroll
            for (int j = 0; j < 4; ++j) red[(kg * 128 + c4 + j) * 9 + r] = acc[r][j];
        __syncthreads();
        if (tid < 128) {
            const int col = cgp * 128 + tid;
            const float bb = b_ada[l * 6144 + col];
#pragma unroll
            for (int r = 0; r < 9; ++r) {
                float s = 0.f;
#pragma unroll
                for (int g = 0; g < 16; ++g) s += red[(g * 128 + tid) * 9 + r];
                modt[((size_t)l * 9 + r) * 6144 + col] = s + bb;
            }
        }
        __syncthreads();
    }
}

DI void tr_tile(const float* src, int src_ld, int k0, int n0, int mode, bf16_t* dst, int dst_ld, int dst_koff, float* tile) {
    const int tid = otid();
    {   const int nn4 = (tid & 15) * 4; const int np = n0 + nn4;
        int col = np; bool valid = true;
        if (mode == 1) valid = np < IN_DIM;
        if (mode == 3) valid = false;
        if (mode == 2) { const int pn = np >> 8, bj = (np >> 7) & 1, jj = np & 127; col = bj * DFF + pn * 128 + jj; }
#pragma unroll
        for (int i = 0; i < 2; ++i) { const int kk = (tid >> 4) + 32 * i;
            f32x4 v = (f32x4){0.f, 0.f, 0.f, 0.f};
            if (valid) v = __builtin_nontemporal_load((const f32x4*)(src + (size_t)(k0 + kk) * src_ld + col));
            tile[kk * 65 + nn4] = v[0]; tile[kk * 65 + nn4 + 1] = v[1]; tile[kk * 65 + nn4 + 2] = v[2]; tile[kk * 65 + nn4 + 3] = v[3]; }
    }
    __syncthreads();
    {   const int nn = tid >> 3, ks = (tid & 7) * 8;
        float v[8];
#pragma unroll
        for (int j = 0; j < 8; ++j) v[j] = tile[(ks + j) * 65 + nn];
        u32x4 o; o[0] = pk_bf16(v[0], v[1]); o[1] = pk_bf16(v[2], v[3]); o[2] = pk_bf16(v[4], v[5]); o[3] = pk_bf16(v[6], v[7]);
        *(u32x4*)(dst + (size_t)(n0 + nn) * dst_ld + dst_koff + k0 + ks) = o;
    }
    __syncthreads();
}

constexpr int T0 = 1280, T1 = T0 + 128, T2 = T1 + 64, T2b = T2 + 64, T2c = T2b + 64, T3 = T2c + 64, T4 = T3 + 256, T5 = T4 + 1408, T6 = T5 + 704;
DI void phase_convert_weights(unsigned char* ws, int l, unsigned char* lds, int t_lo, int t_hi, int bid_off) {
    float* tile = (float*)lds;
    if (bid_off > ogrid() / 2) bid_off = 0;
    if (obid() < bid_off) return;
    for (int it = t_lo + (obid() - bid_off); it < t_hi; it += ogrid() - bid_off) {
        if (it < T0) { const int nt = it / 16, kt = it % 16;
            tr_tile(PIN(10) + (size_t)l * 1024 * IN_DIM, IN_DIM, kt * 64, nt * 64, 1, (bf16_t*)(ws + WS_WIN), 1024, 0, tile);
        } else if (it < T1) { const int j = it - T0, nt = j / 8, kt = j % 8;
            tr_tile(PIN(17) + (size_t)l * 512 * 1024, 1024, kt * 64, nt * 64, 0, (bf16_t*)(ws + WS_WBR), 512, 0, tile);
        } else if (it < T2) { const int j = it - T1, nt = j / 4, kt = j % 4;
            tr_tile(PIN(18) + (size_t)l * 256 * 1024, 1024, kt * 64, nt * 64, 0, (bf16_t*)(ws + WS_WBR) + 1024 * 512, 512, 0, tile);
        } else if (it < T2b) { const int j = it - T2, nt = j / 4, kt = j % 4;
            tr_tile(PIN(18), 1024, kt * 64, nt * 64, 3, (bf16_t*)(ws + WS_WBR) + 1024 * 512, 512, 256, tile);
        } else if (it < T2c) { const int j = it - T2b, nt = j / 4, kt = j % 4;
            tr_tile(PIN(19), 1024, kt * 64, nt * 64, 3, (bf16_t*)(ws + WS_WBR) + 2048 * 512, 512, 0, tile);
        } else if (it < T3) { const int j = it - T2c, nt = j / 4, kt = j % 4;
            tr_tile(PIN(19) + (size_t)l * 256 * 1024, 1024, kt * 64, nt * 64, 0, (bf16_t*)(ws + WS_WBR) + 2048 * 512, 512, 256, tile);
        } else if (it < T4) { const int j = it - T3, nt = j / 16, kt = j % 16;
            tr_tile(PIN(20) + (size_t)l * 1024 * 1024, 1024, kt * 64, nt * 64, 0, (bf16_t*)(ws + WS_WO), 1024, 0, tile);
        } else if (it < T5) { const int j = it - T4, nt = j / 16, kt = j % 16;
            tr_tile(PIN(21) + (size_t)l * 1024 * UPN, UPN, kt * 64, nt * 64, 2, (bf16_t*)(ws + WS_WUP), 1024, 0, tile);
        } else { const int j = it - T5, nt = j / 44, kt = j % 44;
            tr_tile(PIN(24) + (size_t)l * DFF * 1024, 1024, kt * 64, nt * 64, 0, (bf16_t*)(ws + WS_WDN), DFF, 0, tile);
        }
    }
}

DI void phase_rowpass(unsigned char* ws, int nrows, const float* xin_lat, const float* xin_ctx, const float* y, const float* gate_base  ,
                      const float* gpost, bool write_x, bool write_h, const float* hmod_base  , int sc_which, int sh_which, const float* gpre) {
    const int lane = otid() & 63, wave = otid() >> 6;
    float eps = EPS; asm volatile("" : "+v"(eps));
    float* xout_lat = (float*)PIN(25); float* xout_ctx = (float*)(ws + WS_CTXRES);
    bf16_t* H = (bf16_t*)(ws + WS_H);
    const int nwv = ogrid() * 8, per = (nrows + nwv - 1) / nwv;
    int r = (obid() * 8 + wave) * per;
    const int rend = min(r + per, nrows);
    f32x4 xv[4], yv[4], xnx[4], ynx[4];
    f32x4 vgt[4], vgp[4], vpre[4], vsc[4], vsh[4];
#pragma unroll
    for (int i = 0; i < 4; ++i) { xv[i] = (f32x4){0.f, 0.f, 0.f, 0.f}; yv[i] = xv[i]; xnx[i] = xv[i]; ynx[i] = xv[i]; vgt[i] = xv[i]; vgp[i] = xv[i]; vpre[i] = xv[i]; vsc[i] = xv[i]; vsh[i] = xv[i]; }
    if (r < rend) {
        const float* xi = r < ML ? xin_lat + (size_t)r * 1024 : xin_ctx + (size_t)(r - ML) * 1024;
#pragma unroll
        for (int i = 0; i < 4; ++i) xv[i] = __builtin_nontemporal_load((const f32x4*)(xi + i * 256 + lane * 4));
        if (y) {
#pragma unroll
            for (int i = 0; i < 4; ++i) yv[i] = __builtin_nontemporal_load((const f32x4*)(y + (size_t)r * 1024 + i * 256 + lane * 4));
        }
#pragma unroll
        for (int i = 0; i < 4; ++i) { if (y) vgp[i] = *(const f32x4*)(gpost + i * 256 + lane * 4); if (write_h) vpre[i] = *(const f32x4*)(gpre + i * 256 + lane * 4); }
    }
    int mi_cur = -1;
#pragma unroll 1
    for (; r < rend; ++r) {
        const int mi = r < ML ? (r >> 12) : 8;
        const int rn = r + 1;
        if (rn < rend) {
            const float* xi = rn < ML ? xin_lat + (size_t)rn * 1024 : xin_ctx + (size_t)(rn - ML) * 1024;
#pragma unroll
            for (int i = 0; i < 4; ++i) xnx[i] = __builtin_nontemporal_load((const f32x4*)(xi + i * 256 + lane * 4));
            if (y) {
#pragma unroll
                for (int i = 0; i < 4; ++i) ynx[i] = __builtin_nontemporal_load((const f32x4*)(y + (size_t)rn * 1024 + i * 256 + lane * 4));
            }
        }
        if (mi != mi_cur) {
            mi_cur = mi;
#pragma unroll
            for (int i = 0; i < 4; ++i) {
                if (y) vgt[i] = *(const f32x4*)(gate_base + (size_t)mi * 6144 + i * 256 + lane * 4);
                if (write_h) { vsc[i] = *(const f32x4*)(hmod_base + ((size_t)mi * 6 + sc_which) * 1024 + i * 256 + lane * 4);
                               vsh[i] = *(const f32x4*)(hmod_base + ((size_t)mi * 6 + sh_which) * 1024 + i * 256 + lane * 4); }
            }
        }
        if (y) {
            float ss = 0.f;
#pragma unroll
            for (int i = 0; i < 4; ++i) ss += yv[i][0] * yv[i][0] + yv[i][1] * yv[i][1] + yv[i][2] * yv[i][2] + yv[i][3] * yv[i][3];
            ss = wave_sum(ss);
            const float rs = rsqrtf(ss * (1.f / 1024.f) + eps);
#pragma unroll
            for (int i = 0; i < 4; ++i)
#pragma unroll
                for (int j = 0; j < 4; ++j) xv[i][j] += vgt[i][j] * (yv[i][j] * rs * vgp[i][j]);
        }
        if (write_x) {
            float* xo = r < ML ? xout_lat + (size_t)r * 1024 : xout_ctx + (size_t)(r - ML) * 1024;
#pragma unroll
            for (int i = 0; i < 4; ++i) __builtin_nontemporal_store(xv[i], (f32x4*)(xo + i * 256 + lane * 4));
        }
        if (write_h) {
            float ss = 0.f;
#pragma unroll
            for (int i = 0; i < 4; ++i) ss += xv[i][0] * xv[i][0] + xv[i][1] * xv[i][1] + xv[i][2] * xv[i][2] + xv[i][3] * xv[i][3];
            ss = wave_sum(ss);
            const float rs = rsqrtf(ss * (1.f / 1024.f) + eps);
#pragma unroll
            for (int i = 0; i < 4; ++i) {
                float hv[4];
#pragma unroll
                for (int j = 0; j < 4; ++j) hv[j] = (xv[i][j] * rs * vpre[i][j]) * (1.f + vsc[i][j]) + vsh[i][j];
                u32x2 o; o[0] = pk_bf16(hv[0], hv[1]); o[1] = pk_bf16(hv[2], hv[3]);
                *(u32x2*)(H + (size_t)r * 1024 + i * 256 + lane * 4) = o;
            }
        }
#pragma unroll
        for (int i = 0; i < 4; ++i) { xv[i] = xnx[i]; yv[i] = ynx[i]; }
    }
}

DI void attn_item(const bf16_t* P, bf16_t* Y, const float* sinkp, const float* rope, unsigned char* lds, bool is_ctx, int b, int blk, int hp) {
    bf16_t* Ks = (bf16_t*)lds;
    const int tid = otid(), wave = tid >> 6, lane = tid & 63, fr = lane & 15, fq = lane >> 4;
    const int kvh = hp >> 1, h = hp * 2 + (wave >> 2);
    const size_t qrow0 = is_ctx ? (size_t)ML + b * 256 + blk * 128 : (size_t)b * 4096 + blk * 128;
    const int qi0 = (wave & 3) * 32 + fr;
    const int sp0 = is_ctx ? 2 : (blk == 0 ? 1 : 0), sp1 = is_ctx ? 4 : (blk == 31 ? 4 : 5);
    u32x4 rk0, rk1, rv0, rv1; f32x4 rrt[4];
    const int skey = tid >> 2, sdq = tid & 3;
#define ATT_LOAD(sp_) do { const int ch_ = (sp_) < 2 ? (sp_) : ((sp_) < 4 ? (sp_) + 1 : 2); size_t kr_; \
        if (ch_ < 3) { const int kb_ = is_ctx ? 0 : blk - 1 + ch_; kr_ = (size_t)b * 4096 + kb_ * 128; \
            const int tk_ = kb_ * 128 + skey; const int pos_ = sdq < 2 ? (tk_ >> 6) : (tk_ & 63); const float* rt_ = rope + (pos_ * 16 + (sdq & 1) * 8) * 2; \
            _Pragma("unroll") for (int j_ = 0; j_ < 4; ++j_) rrt[j_] = *(const f32x4*)(rt_ + 4 * j_); } \
        else kr_ = (size_t)ML + b * 256 + (ch_ - 3) * 128; \
        const bf16_t* kp_ = P + (kr_ + skey) * IN_DIM + C_AK + kvh * 64 + sdq * 8; rk0 = *(const u32x4*)kp_; rk1 = *(const u32x4*)(kp_ + 32); \
        const bf16_t* vp_ = P + (kr_ + skey) * IN_DIM + C_AV + kvh * 64 + sdq * 8; rv0 = *(const u32x4*)vp_; rv1 = *(const u32x4*)(vp_ + 32); } while (0)
    ATT_LOAD(sp0);
    bf16x8 Qf0[2], Qf1[2];
#pragma unroll
    for (int t = 0; t < 2; ++t) {
        const int qi = qi0 + 16 * t, tq = blk * 128 + qi;
        const bf16_t* qp = P + (qrow0 + qi) * IN_DIM + C_AQ + h * 64 + fq * 8;
        const u32x4 q0 = *(const u32x4*)qp, q1 = *(const u32x4*)(qp + 32);
        float qa[8], qb[8];
#pragma unroll
        for (int j = 0; j < 4; ++j) { qa[2 * j] = lo_f(q0[j]); qa[2 * j + 1] = hi_f(q0[j]); qb[2 * j] = lo_f(q1[j]); qb[2 * j + 1] = hi_f(q1[j]); }
        if (!is_ctx) {
            const int pos = fq < 2 ? (tq >> 6) : (tq & 63);
            const float* rt = rope + (pos * 16 + (fq & 1) * 8) * 2;
#pragma unroll
            for (int j = 0; j < 8; ++j) { const float c = rt[2 * j], s = rt[2 * j + 1]; const float a = qa[j], bb = qb[j]; qa[j] = a * c - bb * s; qb[j] = a * s + bb * c; }
        }
        const float qs = 0.125f * 1.4426950408889634f;
        u32x4 o0, o1;
#pragma unroll
        for (int j = 0; j < 4; ++j) { o0[j] = pk_bf16(qa[2 * j] * qs, qa[2 * j + 1] * qs); o1[j] = pk_bf16(qb[2 * j] * qs, qb[2 * j + 1] * qs); }
        Qf0[t] = __builtin_bit_cast(bf16x8, o0); Qf1[t] = __builtin_bit_cast(bf16x8, o1);
    }
    float m_run[2], l_run[2];
    f32x4 O[2][4];
    {   const float sk = sinkp[h] * 1.4426950408889634f;
#pragma unroll
        for (int t = 0; t < 2; ++t) { m_run[t] = sk; l_run[t] = 1.f;
#pragma unroll
            for (int dt = 0; dt < 4; ++dt) O[t][dt] = (f32x4){0.f, 0.f, 0.f, 0.f}; } }
    __syncthreads();
#pragma unroll 1
    for (int sp = sp0; sp < sp1; ++sp) {
        const int ch = sp < 2 ? sp : (sp < 4 ? sp + 1 : 2);
        const int mask = (ch < 3 && !is_ctx) ? ch : 1;
        const int bufsel = (sp - sp0) & 1;
        bf16_t* Kb = Ks + bufsel * (2 * 128 * 72);
        bf16_t* Vb = Kb + 128 * 72;
        {
            u32x4 k0 = rk0, k1 = rk1;
            if (ch < 3) {
                float ka[8], kb2[8];
#pragma unroll
                for (int j = 0; j < 4; ++j) { ka[2 * j] = lo_f(k0[j]); ka[2 * j + 1] = hi_f(k0[j]); kb2[2 * j] = lo_f(k1[j]); kb2[2 * j + 1] = hi_f(k1[j]); }
#pragma unroll
                for (int j = 0; j < 8; ++j) { const float c = rrt[j >> 1][(j & 1) * 2], s = rrt[j >> 1][(j & 1) * 2 + 1]; const float a = ka[j], bb = kb2[j]; ka[j] = a * c - bb * s; kb2[j] = a * s + bb * c; }
#pragma unroll
                for (int j = 0; j < 4; ++j) { k0[j] = pk_bf16(ka[2 * j], ka[2 * j + 1]); k1[j] = pk_bf16(kb2[2 * j], kb2[2 * j + 1]); }
            }
            *(u32x4*)(Kb + skey * 72 + sdq * 8) = k0;
            *(u32x4*)(Kb + skey * 72 + 32 + sdq * 8) = k1;
            *(u32x4*)(Vb + skey * 72 + sdq * 8) = rv0;
            *(u32x4*)(Vb + skey * 72 + 32 + sdq * 8) = rv1;
        }
        if (sp + 1 < sp1) ATT_LOAD(sp + 1);
        __syncthreads();
        f32x4 S[2][8];
#pragma unroll
        for (int kt = 0; kt < 8; ++kt) {
            const bf16x8 a0 = *(const bf16x8*)(Kb + (kt * 16 + fr) * 72 + fq * 8);
            const bf16x8 a1 = *(const bf16x8*)(Kb + (kt * 16 + fr) * 72 + 32 + fq * 8);
#pragma unroll
            for (int t = 0; t < 2; ++t) {
                f32x4 z = (f32x4){0.f, 0.f, 0.f, 0.f};
                z = __builtin_amdgcn_mfma_f32_16x16x32_bf16(a0, Qf0[t], z, 0, 0, 0);
                S[t][kt] = __builtin_amdgcn_mfma_f32_16x16x32_bf16(a1, Qf1[t], z, 0, 0, 0);
            }
        }
#pragma unroll
        for (int t = 0; t < 2; ++t) {
            if (mask != 1) {
                int dq = qi0 + 16 * t - fq * 4; float negbig = -1e30f; asm volatile("" : "+v"(dq), "+v"(negbig));
                if (mask == 2) dq = -dq;
#pragma unroll
                for (int kt = 0; kt < 8; ++kt)
#pragma unroll
                    for (int j = 0; j < 4; ++j) { const int kk = kt * 16 + j; const bool ok = (mask == 0) ? (kk >= dq) : (-kk >= dq); if (!ok) S[t][kt][j] = negbig; }
            }
            float mx = -1e30f;
#pragma unroll
            for (int kt = 0; kt < 8; ++kt)
#pragma unroll
                for (int j = 0; j < 4; ++j) mx = fmaxf(mx, S[t][kt][j]);
            mx = fmaxf(mx, shx(mx, 16, lane)); mx = fmaxf(mx, shx(mx, 32, lane));
            const float m_new = fmaxf(m_run[t], mx);
            const float alpha = __builtin_amdgcn_exp2f(m_run[t] - m_new);
            float sum = 0.f;
#pragma unroll
            for (int kt = 0; kt < 8; ++kt)
#pragma unroll
                for (int j = 0; j < 4; ++j) { const float e = __builtin_amdgcn_exp2f(S[t][kt][j] - m_new); S[t][kt][j] = e; sum += e; }
            sum += shx(sum, 16, lane); sum += shx(sum, 32, lane);
            l_run[t] = l_run[t] * alpha + sum; m_run[t] = m_new;
#pragma unroll
            for (int dt = 0; dt < 4; ++dt)
#pragma unroll
                for (int j = 0; j < 4; ++j) O[t][dt][j] *= alpha;
        }
#pragma unroll
        for (int i = 0; i < 4; ++i) {
            bf16x8 Pf[2];
#pragma unroll
            for (int t = 0; t < 2; ++t) {
                u32x4 pw; pw[0] = pk_bf16(S[t][2 * i][0], S[t][2 * i][1]); pw[1] = pk_bf16(S[t][2 * i][2], S[t][2 * i][3]); pw[2] = pk_bf16(S[t][2 * i + 1][0], S[t][2 * i + 1][1]); pw[3] = pk_bf16(S[t][2 * i + 1][2], S[t][2 * i + 1][3]);
                Pf[t] = __builtin_bit_cast(bf16x8, pw);
            }
#pragma unroll
            for (int dt = 0; dt < 4; ++dt) {
                const s16x4 lo = __builtin_amdgcn_ds_read_tr16_b64_v4i16((LAS s16x4*)(Vb + (32 * i + fq * 4 + (fr >> 2)) * 72 + dt * 16 + 4 * (fr & 3)));
                const s16x4 hi = __builtin_amdgcn_ds_read_tr16_b64_v4i16((LAS s16x4*)(Vb + (32 * i + 16 + fq * 4 + (fr >> 2)) * 72 + dt * 16 + 4 * (fr & 3)));
                const bf16x8 Vf = __builtin_shufflevector(lo, hi, 0, 1, 2, 3, 4, 5, 6, 7);
#pragma unroll
                for (int t = 0; t < 2; ++t) O[t][dt] = __builtin_amdgcn_mfma_f32_16x16x32_bf16(Vf, Pf[t], O[t][dt], 0, 0, 0);
            }
        }
    }
#undef ATT_LOAD
#pragma unroll
    for (int t = 0; t < 2; ++t) {
        const float inv = 1.f / l_run[t];
        bf16_t* yp = Y + (qrow0 + qi0 + 16 * t) * 1024 + h * 64 + fq * 4;
#pragma unroll
        for (int dt = 0; dt < 4; ++dt) { u32x2 o; o[0] = pk_bf16(O[t][dt][0] * inv, O[t][dt][1] * inv); o[1] = pk_bf16(O[t][dt][2] * inv, O[t][dt][3] * inv); *(u32x2*)(yp + dt * 16) = o; }
    }
    __syncthreads();
}

template <int W> DI void pool_window(const bf16_t* us, bf16_t* dd, int tid, int chn, int t0, int T) {
    constexpr int lo = W / 2, hi = W - lo - 1;
#pragma unroll 2
    for (int i = 0; i < 32; ++i) {
        const int tt = (tid >> 8) + 2 * i, t = t0 + tt;
        float s = 0.f;
#pragma unroll
        for (int k = -lo; k <= hi; ++k) s += bf2f(us[(tt + 8 + k) * 256 + chn]);
        const int cnt = min(t + hi + 1, T) - max(t - lo, 0);
        dd[tt * 264 + chn] = f2bf(s / (float)cnt - bf2f(us[(tt + 8) * 256 + chn]));
    }
}

DI void pool_item(const bf16_t* P, bf16_t* Y, const float* pool_w, const float* pool_scale, unsigned char* lds, int cid) {
    bf16_t* us = (bf16_t*)lds;
    bf16_t* dd = (bf16_t*)(lds + 79 * 256 * 2 + 64);
    bf16_t* Wt = dd + 64 * 264;
    const int tid = otid();
    const int row0 = cid * 64;
    int seq0, T;
    if (cid < 512) { seq0 = (cid >> 6) * 4096; T = 4096; } else { seq0 = ML + ((cid - 512) >> 2) * 256; T = 256; }
    const int t0 = row0 - seq0;
    __syncthreads();
#pragma unroll
    for (int i = 0; i < 5; ++i) {
        const int c = tid + i * NTHR;
        if (c < 79 * 32) {
            const int rr = c >> 5, cc = (c & 31) * 8; const int t = t0 - 8 + rr;
            u32x4 v = (u32x4){0u, 0u, 0u, 0u};
            if (t >= 0 && t < T) v = *(const u32x4*)(P + (size_t)(seq0 + t) * IN_DIM + C_PU + cc);
            *(u32x4*)(us + rr * 256 + cc) = v;
        }
    }
#pragma unroll
    for (int i = 0; i < 8; ++i) {
        const int c = tid + i * NTHR; const int gi = c >> 4, o4 = (c & 15) * 4;
        const f32x4 wv = *(const f32x4*)(pool_w + (size_t)gi * 64 + o4);
        u32x2 wo; wo[0] = pk_bf16(wv[0], wv[1]); wo[1] = pk_bf16(wv[2], wv[3]);
        *(u32x2*)(Wt + gi * 72 + o4) = wo;
    }
    __syncthreads();
    {
        const int chn = tid & 255, g = chn >> 6;
        if (g == 0) pool_window<2>(us, dd, tid, chn, t0, T);
        else if (g == 1) pool_window<4>(us, dd, tid, chn, t0, T);
        else if (g == 2) pool_window<8>(us, dd, tid, chn, t0, T);
        else pool_window<16>(us, dd, tid, chn, t0, T);
    }
    __syncthreads();
    {
        const int lane = tid & 63, fr = lane & 15, fq = lane >> 4, w = tid >> 6, g = w >> 1, th = w & 1;
#pragma unroll
        for (int mt = 0; mt < 2; ++mt)
#pragma unroll
            for (int nt = 0; nt < 4; ++nt) {
                f32x4 acc = (f32x4){0.f, 0.f, 0.f, 0.f};
#pragma unroll
                for (int ks = 0; ks < 2; ++ks) {
                    const bf16x8 a = *(const bf16x8*)(dd + (th * 32 + mt * 16 + fr) * 264 + g * 64 + ks * 32 + fq * 8);
                    const int wr_ = g * 64 + ks * 32 + fq * 8 + (fr >> 2), wc_ = nt * 16 + 4 * (fr & 3);
                    const s16x4 b0 = __builtin_amdgcn_ds_read_tr16_b64_v4i16((LAS s16x4*)(Wt + wr_ * 72 + wc_)), b1 = __builtin_amdgcn_ds_read_tr16_b64_v4i16((LAS s16x4*)(Wt + (wr_ + 4) * 72 + wc_));
                    const bf16x8 b = __builtin_shufflevector(b0, b1, 0, 1, 2, 3, 4, 5, 6, 7);
                    acc = __builtin_amdgcn_mfma_f32_16x16x32_bf16(b, a, acc, 0, 0, 0);
                }
                const f32x4 ps = *(const f32x4*)(pool_scale + g * 64 + nt * 16 + fq * 4);
                u32x2 o; o[0] = pk_bf16(acc[0] * ps[0], acc[1] * ps[1]); o[1] = pk_bf16(acc[2] * ps[2], acc[3] * ps[3]);
                *(u32x2*)(Y + (size_t)(row0 + th * 32 + mt * 16 + fr) * 1024 + 512 + g * 64 + nt * 16 + fq * 4) = o;
            }
    }
}

constexpr int GL_Q = 0, GL_K = GL_Q + 64 * 33, GL_V = GL_K + 64 * 33, GL_G = GL_V + 64 * 68, GL_BF = GL_G + 64 * 33, GL_BB = GL_BF + 64 * 33,
              GL_QT = GL_BB + 64 * 33, GL_KT = GL_QT + 64 * 33, GL_ATT = GL_KT + 64 * 33, GL_S = GL_ATT + 64 * 68, GL_END = GL_S + 32 * 68;
static_assert(GL_END * 4 <= 131072, "gla lds");
constexpr int G3_B0 = GL_QT * 4;
constexpr int G3_QT = G3_B0, G3_KT = G3_QT + 2 * 64 * 40 * 2, G3_ATT = G3_KT + 2 * 64 * 40 * 2, G3_VT = G3_ATT + 2 * 64 * 72 * 2,
              G3_ST = G3_VT + 64 * 72 * 2, G3_END = G3_ST + 2 * 32 * 72 * 2;
static_assert(G3_END <= 131072, "gla3 lds");

DI void gla_load(const bf16_t* P, const float* wa2  , const float* ba  , float* L, int cid, int hh) {
    const int tid = otid();
    const size_t row0 = (size_t)cid * 64;
    __syncthreads();
    {
        const int r = tid >> 3, d0 = (tid & 7) * 4;
        const bf16_t* rp = P + (row0 + r) * IN_DIM;
        const u32x2 kv = *(const u32x2*)(rp + C_GK + hh * 32 + d0), gv = *(const u32x2*)(rp + C_GLR + d0);
        L[GL_K + r * 33 + d0] = lo_f(kv[0]); L[GL_K + r * 33 + d0 + 1] = hi_f(kv[0]); L[GL_K + r * 33 + d0 + 2] = lo_f(kv[1]); L[GL_K + r * 33 + d0 + 3] = hi_f(kv[1]);
        L[GL_G + r * 33 + d0] = lo_f(gv[0]); L[GL_G + r * 33 + d0 + 1] = hi_f(gv[0]); L[GL_G + r * 33 + d0 + 2] = lo_f(gv[1]); L[GL_G + r * 33 + d0 + 3] = hi_f(gv[1]);
        const int e0 = (tid & 7) * 8;
        const u32x4 vv = *(const u32x4*)(rp + C_GV + hh * 64 + e0);
        {
            const int idx = tid * 2, wd = idx >> 9, wr_ = (idx >> 5) & 15, wdd = idx & 31;
            const f32x2 wv2 = *(const f32x2*)(wa2 + (wd * 16 + wr_) * 128 + hh * 32 + wdd);
            *(f32x2*)(L + GL_S + idx) = wv2;
            if (tid < 64) L[GL_S + 1024 + tid] = ba[(tid >> 5) * 128 + hh * 32 + (tid & 31)];
        }
        *(u32x4*)((bf16_t*)((unsigned char*)L + G3_VT) + r * 72 + e0) = vv;
    }
    __syncthreads();
    {
        const int r = tid >> 3, d0 = (tid & 7) * 4;
#pragma unroll
        for (int dir = 0; dir < 2; ++dir) {
            f32x4 z = *(const f32x4*)(L + GL_S + 1024 + dir * 32 + d0);
#pragma unroll
            for (int rr = 0; rr < 16; ++rr) {
                const float gl = L[GL_G + r * 33 + dir * 16 + rr];
                const f32x4 w = *(const f32x4*)(L + GL_S + (dir * 16 + rr) * 32 + d0);
                z[0] += gl * w[0]; z[1] += gl * w[1]; z[2] += gl * w[2]; z[3] += gl * w[3];
            }
#pragma unroll
            for (int j = 0; j < 4; ++j) {
                const float zz = z[j];
                const float ls = fminf(zz, 0.f) - __logf(1.f + __expf(-fabsf(zz)));
                L[(dir ? GL_BB : GL_BF) + r * 33 + d0 + j] = ls * (1.f / 16.f);
            }
        }
    }
    __syncthreads();
    {
        const int lane = tid & 63, wv = tid >> 6;
#pragma unroll
        for (int c = 0; c < 4; ++c) {
            const int d = wv * 4 + c;
            float vf = L[GL_BF + lane * 33 + d], vb = L[GL_BB + lane * 33 + d];
#pragma unroll
            for (int off = 1; off < 64; off <<= 1) {
                const float tf = __int_as_float(__builtin_amdgcn_ds_bpermute(((lane - off) & 63) << 2, __float_as_int(vf)));
                const float tb = __int_as_float(__builtin_amdgcn_ds_bpermute(((lane + off) & 63) << 2, __float_as_int(vb)));
                vf += (lane >= off) ? tf : 0.f;
                vb += (lane + off < 64) ? tb : 0.f;
            }
            L[GL_BF + lane * 33 + d] = vf; L[GL_BB + lane * 33 + d] = vb;
        }
    }
    __syncthreads();
}

DI void gla_load3(const bf16_t* P, const float* GBi, float* L, int cid, int hh) {
    const int tid = otid();
    const size_t row0 = (size_t)cid * 64;
    __syncthreads();
    {
        const int r = tid >> 3, d0 = (tid & 7) * 4;
        const bf16_t* rp = P + (row0 + r) * IN_DIM;
        const u32x2 qv = *(const u32x2*)(rp + C_GQ + hh * 32 + d0), kv = *(const u32x2*)(rp + C_GK + hh * 32 + d0);
        const f32x4 bfv = *(const f32x4*)(GBi + r * 32 + d0), bbv = *(const f32x4*)(GBi + 2048 + r * 32 + d0);
        const int e0 = (tid & 7) * 8;
        const u32x4 vv = *(const u32x4*)(rp + C_GV + hh * 64 + e0);
        const float qs = 0.17677669529663687f;
        L[GL_Q + r * 33 + d0] = lo_f(qv[0]) * qs; L[GL_Q + r * 33 + d0 + 1] = hi_f(qv[0]) * qs; L[GL_Q + r * 33 + d0 + 2] = lo_f(qv[1]) * qs; L[GL_Q + r * 33 + d0 + 3] = hi_f(qv[1]) * qs;
        L[GL_K + r * 33 + d0] = lo_f(kv[0]); L[GL_K + r * 33 + d0 + 1] = hi_f(kv[0]); L[GL_K + r * 33 + d0 + 2] = lo_f(kv[1]); L[GL_K + r * 33 + d0 + 3] = hi_f(kv[1]);
#pragma unroll
        for (int j = 0; j < 4; ++j) { L[GL_BF + r * 33 + d0 + j] = bfv[j]; L[GL_BB + r * 33 + d0 + j] = bbv[j]; }
        *(f32x4*)(L + GL_V + r * 68 + e0) = (f32x4){lo_f(vv[0]), hi_f(vv[0]), lo_f(vv[1]), hi_f(vv[1])};
        *(f32x4*)(L + GL_V + r * 68 + e0 + 4) = (f32x4){lo_f(vv[2]), hi_f(vv[2]), lo_f(vv[3]), hi_f(vv[3])};
    }
    __syncthreads();
}

DI void gla_pass1_item(unsigned char* ws, const float* wa2, const float* gba, unsigned char* lds, int cid, int hh) {
    float* L = (float*)lds;
    const bf16_t* P = (const bf16_t*)(ws + WS_P);
    gla_load(P, wa2, gba, L, cid, hh);
    const int tid = otid();
    float* GKV = (float*)(ws + WS_M2); float* GDEC = (float*)(ws + WS_GDEC);
    {
        float* GB = (float*)(ws + WS_M2) + (size_t)NCH * 4 * 2 * 2048 + ((size_t)cid * 4 + hh) * 4096;
        const int r = tid >> 3, d0 = (tid & 7) * 4;
        *(f32x4*)(GB + r * 32 + d0) = (f32x4){L[GL_BF + r * 33 + d0], L[GL_BF + r * 33 + d0 + 1], L[GL_BF + r * 33 + d0 + 2], L[GL_BF + r * 33 + d0 + 3]};
        *(f32x4*)(GB + 2048 + r * 32 + d0) = (f32x4){L[GL_BB + r * 33 + d0], L[GL_BB + r * 33 + d0 + 1], L[GL_BB + r * 33 + d0 + 2], L[GL_BB + r * 33 + d0 + 3]};
    }
    bf16_t* KD = (bf16_t*)(lds + G3_QT);
    bf16_t* VB = (bf16_t*)(lds + G3_VT);
    {
        const int c = tid >> 3, d0 = (tid & 7) * 4;
        float kf[4], kb[4];
#pragma unroll
        for (int j = 0; j < 4; ++j) {
            const float k = L[GL_K + c * 33 + d0 + j];
            kf[j] = k * __expf(L[GL_BF + 63 * 33 + d0 + j] - L[GL_BF + c * 33 + d0 + j]);
            kb[j] = k * __expf(L[GL_BB + 0 * 33 + d0 + j] - L[GL_BB + c * 33 + d0 + j]);
        }
        u32x2 o;
        o[0] = pk_bf16(kf[0], kf[1]); o[1] = pk_bf16(kf[2], kf[3]); *(u32x2*)(KD + c * 40 + d0) = o;
        o[0] = pk_bf16(kb[0], kb[1]); o[1] = pk_bf16(kb[2], kb[3]); *(u32x2*)(KD + 64 * 40 + c * 40 + d0) = o;
    }
    __syncthreads();
    const size_t idx = ((size_t)cid * 4 + hh) * 2;
    {
        const int lane = tid & 63, fr = lane & 15, fq = lane >> 4, wv = tid >> 6, dir = wv >> 2, et = wv & 3;
        const bf16_t* KDd = KD + dir * 64 * 40;
        f32x4 a0 = (f32x4){0.f, 0.f, 0.f, 0.f}, a1 = a0;
#pragma unroll
        for (int ks = 0; ks < 2; ++ks) {
            const int trr = ks * 32 + fq * 8 + (fr >> 2), trc = 4 * (fr & 3);
            const s16x4 v0 = __builtin_amdgcn_ds_read_tr16_b64_v4i16((LAS s16x4*)(VB + trr * 72 + et * 16 + trc)), v1 = __builtin_amdgcn_ds_read_tr16_b64_v4i16((LAS s16x4*)(VB + (trr + 4) * 72 + et * 16 + trc));
            const s16x4 k00 = __builtin_amdgcn_ds_read_tr16_b64_v4i16((LAS s16x4*)(KDd + trr * 40 + trc)), k01 = __builtin_amdgcn_ds_read_tr16_b64_v4i16((LAS s16x4*)(KDd + (trr + 4) * 40 + trc));
            const s16x4 k10 = __builtin_amdgcn_ds_read_tr16_b64_v4i16((LAS s16x4*)(KDd + trr * 40 + 16 + trc)), k11 = __builtin_amdgcn_ds_read_tr16_b64_v4i16((LAS s16x4*)(KDd + (trr + 4) * 40 + 16 + trc));
            const bf16x8 vf = __builtin_shufflevector(v0, v1, 0, 1, 2, 3, 4, 5, 6, 7);
            const bf16x8 kf0 = __builtin_shufflevector(k00, k01, 0, 1, 2, 3, 4, 5, 6, 7), kf1 = __builtin_shufflevector(k10, k11, 0, 1, 2, 3, 4, 5, 6, 7);
            a0 = __builtin_amdgcn_mfma_f32_16x16x32_bf16(vf, kf0, a0, 0, 0, 0);
            a1 = __builtin_amdgcn_mfma_f32_16x16x32_bf16(vf, kf1, a1, 0, 0, 0);
        }
        float* gk = GKV + (idx + dir) * 2048 + et * 16 + fq * 4;
        *(f32x4*)(gk + (size_t)fr * 64) = a0;
        *(f32x4*)(gk + (size_t)(16 + fr) * 64) = a1;
    }
    if (tid < 32) GDEC[idx * 32 + tid] = __expf(L[GL_BF + 63 * 33 + tid]);
    else if (tid < 64) GDEC[(idx + 1) * 32 + (tid - 32)] = __expf(L[GL_BB + 0 * 33 + (tid - 32)]);
}

DI void phase_gla_scan(unsigned char* ws) {
    float* GKV = (float*)(ws + WS_M2); const float* GDEC = (const float*)(ws + WS_GDEC);
    const int tid = otid();
    for (int vb = obid(); vb < 256; vb += ogrid()) {
        const int sid = vb >> 2, quarter = vb & 3; const int b = sid >> 3, hh = (sid >> 1) & 3, dir = sid & 1;
        const int elem = quarter * 512 + tid, d = elem >> 6;
        float S = 0.f;
        for (int s0 = 0; s0 < 68; s0 += 17) {
            float kv[17], dc[17]; unsigned ix[17];
#pragma unroll
            for (int u = 0; u < 17; ++u) {
                const int s = s0 + u;
                int cid;
                if (dir == 0) cid = s < 4 ? 512 + b * 4 + s : b * 64 + (s - 4);
                else cid = s < 4 ? 512 + b * 4 + (3 - s) : b * 64 + (63 - (s - 4));
                ix[u] = (unsigned)((cid * 4 + hh) * 2 + dir);
                kv[u] = GKV[(size_t)ix[u] * 2048 + elem]; dc[u] = GDEC[ix[u] * 32 + d];
            }
#pragma unroll
            for (int u = 0; u < 17; ++u) { GKV[(size_t)ix[u] * 2048 + elem] = S; S = S * dc[u] + kv[u]; }
        }
    }
}

DI void gla_pass3_item(unsigned char* ws, const float* wa2, const float* gba, const float* gnorm, unsigned char* lds, int cid, int hh) {
    float* L = (float*)lds;
    const bf16_t* P = (const bf16_t*)(ws + WS_P);
    bf16_t* Y = (bf16_t*)(ws + WS_H);
    const int tid = otid(), lane = tid & 63, fr = lane & 15, fq = lane >> 4, wv = tid >> 6, dir = wv >> 2, mt = wv & 3;
    bf16_t* QT = (bf16_t*)(lds + G3_QT); bf16_t* KT = (bf16_t*)(lds + G3_KT); bf16_t* ATT = (bf16_t*)(lds + G3_ATT);
    bf16_t* VT = (bf16_t*)(lds + G3_VT); bf16_t* ST = (bf16_t*)(lds + G3_ST);
    float* OB = L + GL_Q;
    {
        const int c = tid >> 3, d0 = (tid & 7) * 4, e0 = (tid & 7) * 8;
        const bf16_t* rp = P + ((size_t)cid * 64 + c) * IN_DIM;
        const float* GBi = (const float*)(ws + WS_M2) + (size_t)NCH * 4 * 2 * 2048 + ((size_t)cid * 4 + hh) * 4096;
        const u32x2 qv = *(const u32x2*)(rp + C_GQ + hh * 32 + d0), kv = *(const u32x2*)(rp + C_GK + hh * 32 + d0);
        const f32x4 bfv = *(const f32x4*)(GBi + c * 32 + d0), bbv = *(const f32x4*)(GBi + 2048 + c * 32 + d0);
        const u32x4 vv = *(const u32x4*)(rp + C_GV + hh * 64 + e0);
        const int sd = tid >> 8, d = (tid & 255) >> 3;
        const float* GSp = (const float*)(ws + WS_M2) + (((size_t)cid * 4 + hh) * 2 + sd) * 2048 + d * 64 + e0;
        const f32x4 s0 = *(const f32x4*)GSp, s1 = *(const f32x4*)(GSp + 4);
        __syncthreads();
        const float qs = 0.17677669529663687f;
        const float qq[4] = {lo_f(qv[0]) * qs, hi_f(qv[0]) * qs, lo_f(qv[1]) * qs, hi_f(qv[1]) * qs};
        const float kk[4] = {lo_f(kv[0]), hi_f(kv[0]), lo_f(kv[1]), hi_f(kv[1])};
        float qf[4], kf[4], qb[4], kb[4];
#pragma unroll
        for (int j = 0; j < 4; ++j) { qf[j] = qq[j] * __expf(bfv[j]); kf[j] = kk[j] * __expf(-bfv[j]); qb[j] = qq[j] * __expf(bbv[j]); kb[j] = kk[j] * __expf(-bbv[j]); }
        u32x2 o;
        o[0] = pk_bf16(qf[0], qf[1]); o[1] = pk_bf16(qf[2], qf[3]); *(u32x2*)(QT + c * 40 + d0) = o;
        o[0] = pk_bf16(kf[0], kf[1]); o[1] = pk_bf16(kf[2], kf[3]); *(u32x2*)(KT + c * 40 + d0) = o;
        o[0] = pk_bf16(qb[0], qb[1]); o[1] = pk_bf16(qb[2], qb[3]); *(u32x2*)(QT + 64 * 40 + c * 40 + d0) = o;
        o[0] = pk_bf16(kb[0], kb[1]); o[1] = pk_bf16(kb[2], kb[3]); *(u32x2*)(KT + 64 * 40 + c * 40 + d0) = o;
        *(u32x4*)(VT + c * 72 + e0) = vv;
        {   u32x4 so; so[0] = pk_bf16(s0[0], s0[1]); so[1] = pk_bf16(s0[2], s0[3]); so[2] = pk_bf16(s1[0], s1[1]); so[3] = pk_bf16(s1[2], s1[3]);
            *(u32x4*)(ST + sd * 32 * 72 + d * 72 + e0) = so; }
    }
    __syncthreads();
    const bf16_t* QTd = QT + dir * 64 * 40; const bf16_t* KTd = KT + dir * 64 * 40; bf16_t* ATTd = ATT + dir * 64 * 72; const bf16_t* STd = ST + dir * 32 * 72;
    {
        const bf16x8 qfrag = *(const bf16x8*)(QTd + (mt * 16 + fr) * 40 + fq * 8);
        const int i = mt * 16 + fr;
#pragma unroll
        for (int nt = 0; nt < 4; ++nt) {
            const bf16x8 kfrag = *(const bf16x8*)(KTd + (nt * 16 + fr) * 40 + fq * 8);
            f32x4 a = (f32x4){0.f, 0.f, 0.f, 0.f};
            a = __builtin_amdgcn_mfma_f32_16x16x32_bf16(kfrag, qfrag, a, 0, 0, 0);
            float r[4];
#pragma unroll
            for (int jq = 0; jq < 4; ++jq) { const int j = nt * 16 + fq * 4 + jq; const int dji = dir ? (j - i) : (i - j); r[jq] = (dji >= 0) ? a[jq] : 0.f; }
            u32x2 o; o[0] = pk_bf16(r[0], r[1]); o[1] = pk_bf16(r[2], r[3]);
            *(u32x2*)(ATTd + (mt * 16 + fr) * 72 + nt * 16 + fq * 4) = o;
        }
    }
    __syncthreads();
    f32x4 o4[4];
    {
        const bf16x8 af0 = *(const bf16x8*)(ATTd + (mt * 16 + fr) * 72 + fq * 8), af1 = *(const bf16x8*)(ATTd + (mt * 16 + fr) * 72 + 32 + fq * 8);
        const bf16x8 qfrag = *(const bf16x8*)(QTd + (mt * 16 + fr) * 40 + fq * 8);
#pragma unroll
        for (int nt = 0; nt < 4; ++nt) {
            const int trc = nt * 16 + 4 * (fr & 3), trr = fq * 8 + (fr >> 2);
            const s16x4 v0a = __builtin_amdgcn_ds_read_tr16_b64_v4i16((LAS s16x4*)(VT + (trr) * 72 + trc)), v0b = __builtin_amdgcn_ds_read_tr16_b64_v4i16((LAS s16x4*)(VT + (trr + 4) * 72 + trc));
            const s16x4 v1a = __builtin_amdgcn_ds_read_tr16_b64_v4i16((LAS s16x4*)(VT + (32 + trr) * 72 + trc)), v1b = __builtin_amdgcn_ds_read_tr16_b64_v4i16((LAS s16x4*)(VT + (32 + trr + 4) * 72 + trc));
            const s16x4 sfa = __builtin_amdgcn_ds_read_tr16_b64_v4i16((LAS s16x4*)(STd + (trr) * 72 + trc)), sfb = __builtin_amdgcn_ds_read_tr16_b64_v4i16((LAS s16x4*)(STd + (trr + 4) * 72 + trc));
            const bf16x8 v0 = __builtin_shufflevector(v0a, v0b, 0, 1, 2, 3, 4, 5, 6, 7), v1 = __builtin_shufflevector(v1a, v1b, 0, 1, 2, 3, 4, 5, 6, 7), sf = __builtin_shufflevector(sfa, sfb, 0, 1, 2, 3, 4, 5, 6, 7);
            f32x4 a = (f32x4){0.f, 0.f, 0.f, 0.f};
            a = __builtin_amdgcn_mfma_f32_16x16x32_bf16(v0, af0, a, 0, 0, 0);
            a = __builtin_amdgcn_mfma_f32_16x16x32_bf16(v1, af1, a, 0, 0, 0);
            a = __builtin_amdgcn_mfma_f32_16x16x32_bf16(sf, qfrag, a, 0, 0, 0);
            o4[nt] = a;
        }
    }
    if (dir == 1) {
#pragma unroll
        for (int nt = 0; nt < 4; ++nt) {
            float* ob = OB + (mt * 16 + fr) * 66 + nt * 16 + fq * 4;
            *(f32x2*)ob = (f32x2){o4[nt][0], o4[nt][1]}; *(f32x2*)(ob + 2) = (f32x2){o4[nt][2], o4[nt][3]};
        }
    }
    __syncthreads();
    if (dir == 0) {
        float ss = 0.f;
#pragma unroll
        for (int nt = 0; nt < 4; ++nt) {
            const float* ob = OB + (mt * 16 + fr) * 66 + nt * 16 + fq * 4;
            const f32x2 b0 = *(const f32x2*)ob, b1 = *(const f32x2*)(ob + 2);
            o4[nt][0] += b0[0]; o4[nt][1] += b0[1]; o4[nt][2] += b1[0]; o4[nt][3] += b1[1];
            ss += o4[nt][0] * o4[nt][0] + o4[nt][1] * o4[nt][1] + o4[nt][2] * o4[nt][2] + o4[nt][3] * o4[nt][3];
        }
        ss += shx(ss, 16, lane); ss += shx(ss, 32, lane);
        float eps = EPS; asm volatile("" : "+v"(eps));
        const float rs = rsqrtf(ss * (1.f / 64.f) + eps);
        const size_t row = (size_t)cid * 64 + mt * 16 + fr;
#pragma unroll
        for (int nt = 0; nt < 4; ++nt) {
            const int e = nt * 16 + fq * 4;
            const f32x4 gn = *(const f32x4*)(gnorm + hh * 64 + e);
            const u32x2 rv = *(const u32x2*)(P + row * IN_DIM + C_GR + hh * 64 + e);
            const float r0 = lo_f(rv[0]), r1 = hi_f(rv[0]), r2 = lo_f(rv[1]), r3 = hi_f(rv[1]);
            u32x2 ov; ov[0] = pk_bf16(o4[nt][0] * rs * gn[0] * siluf_(r0), o4[nt][1] * rs * gn[1] * siluf_(r1)); ov[1] = pk_bf16(o4[nt][2] * rs * gn[2] * siluf_(r2), o4[nt][3] * rs * gn[3] * siluf_(r3));
            *(u32x2*)(Y + row * 1024 + 768 + hh * 64 + e) = ov;
        }
    }
}

DI void phase_conv_fixup(const float* EDGE, bf16_t* ACT, const float* cw, const float* cb) {
    const int ntask = 128 * 2 * 704;
    for (int task = obid() * NTHR + otid(); task < ntask; task += ogrid() * NTHR) {
        const int jg = task % 704, tw = task / 704, which = tw & 1, pm = tw >> 1;
        const int j0 = jg * 4, ucol = (j0 >> 7) * 256 + (j0 & 127);
        const float *pr, *cu, *nx; int row;
        if (which == 0) { if ((pm & 15) == 0) continue; pr = EDGE + ((size_t)(pm - 1) * 4 + 3) * UPN; cu = EDGE + ((size_t)pm * 4 + 0) * UPN; nx = EDGE + ((size_t)pm * 4 + 1) * UPN; row = pm * 256; }
        else { if ((pm & 15) == 15) continue; pr = EDGE + ((size_t)pm * 4 + 2) * UPN; cu = EDGE + ((size_t)pm * 4 + 3) * UPN; nx = EDGE + ((size_t)(pm + 1) * 4 + 0) * UPN; row = pm * 256 + 255; }
        const f32x4 pa = *(const f32x4*)(pr + ucol), pg = *(const f32x4*)(pr + ucol + 128), ca = *(const f32x4*)(cu + ucol), cg_ = *(const f32x4*)(cu + ucol + 128), na = *(const f32x4*)(nx + ucol), ng = *(const f32x4*)(nx + ucol + 128);
        const f32x4 w0a = *(const f32x4*)(cw + j0), w1a = *(const f32x4*)(cw + UPN + j0), w2a = *(const f32x4*)(cw + 2 * UPN + j0), bba = *(const f32x4*)(cb + j0);
        const f32x4 w0g = *(const f32x4*)(cw + DFF + j0), w1g = *(const f32x4*)(cw + UPN + DFF + j0), w2g = *(const f32x4*)(cw + 2 * UPN + DFF + j0), bbg = *(const f32x4*)(cb + DFF + j0);
        float r[4];
#pragma unroll
        for (int e = 0; e < 4; ++e) { const float av = w0a[e] * pa[e] + w1a[e] * ca[e] + w2a[e] * na[e] + bba[e]; const float gv = w0g[e] * pg[e] + w1g[e] * cg_[e] + w2g[e] * ng[e] + bbg[e]; r[e] = av * siluf_(gv); }
        u32x2 o; o[0] = pk_bf16(r[0], r[1]); o[1] = pk_bf16(r[2], r[3]);
        *(u32x2*)(ACT + (size_t)row * DFF + j0) = o;
    }
}

DI void phase_merge_sum(const bf16_t* P, bf16_t* M2, int nrows) {
    const int lane = otid() & 63, wave = otid() >> 6;
    for (int r = obid() * 8 + wave; r < nrows; r += ogrid() * 8) {
        const bf16_t* gp = P + (size_t)r * IN_DIM + C_MG + lane * 8;
        u32x4 v[3][2];
#pragma unroll
        for (int b = 0; b < 3; ++b)
#pragma unroll
            for (int i = 0; i < 2; ++i) v[b][i] = __builtin_nontemporal_load((const u32x4*)(gp + b * 1024 + i * 512));
#pragma unroll
        for (int i = 0; i < 2; ++i) {
            u32x4 o;
#pragma unroll
            for (int j = 0; j < 4; ++j) o[j] = pk_bf16(lo_f(v[0][i][j]) + lo_f(v[1][i][j]) + lo_f(v[2][i][j]), hi_f(v[0][i][j]) + hi_f(v[1][i][j]) + hi_f(v[2][i][j]));
            *(u32x4*)(M2 + (size_t)r * 1024 + i * 512 + lane * 8) = o;
        }
    }
}

#define XB_TMO      128
#define XB_XCNT(j)  (256  + 64 * (j))
#define XB_XSUB(j)  (1280 + 64 * (j))
#define XB_XGEN(j)  (2304 + 64 * (j))
#define XB_TOP      3328
#define XB_TOPGEN   3392
#define XCD_BAR_WORDS 3456
#define XB_SPIN_CAP (1u << 18)
DI unsigned xb_ld(unsigned* p)              { return __hip_atomic_load(p, __ATOMIC_RELAXED, __HIP_MEMORY_SCOPE_AGENT); }
DI unsigned xb_add(unsigned* p, unsigned v) { return __hip_atomic_fetch_add(p, v, __ATOMIC_RELAXED, __HIP_MEMORY_SCOPE_AGENT); }
DI unsigned xb_xcc_id() { return (unsigned)__builtin_amdgcn_s_getreg((3 << 11) | 20) & 0xFu; }
#define XB_SPIN(cond, bar) do { unsigned _sp = 0; while (cond) { __builtin_amdgcn_s_sleep(1); \
    if ((++_sp & 255u) == 0u) { if (xb_ld(&(bar)[XB_TMO])) break; if (_sp > XB_SPIN_CAP) { atomicAdd(&(bar)[XB_TMO], 1u); break; } } } } while (0)
struct XcdBarrier { unsigned* bar; unsigned x; volatile LAS unsigned* st; };
DI XcdBarrier xcd_barrier_post(unsigned* bar, volatile LAS unsigned* st) {
    XcdBarrier b; b.bar = bar; b.x = xb_xcc_id(); b.st = st;
    if (threadIdx.x == 0) (void)xb_add(&bar[XB_XCNT(b.x)], 1u);
    return b;
}
DI void xcd_barrier_complete(unsigned* bar, unsigned x, unsigned& nloc, unsigned& nx) {
    const unsigned G = gridDim.x * gridDim.y * gridDim.z;
    unsigned sum, cnt, mine, sp = 0u;
    for (;;) {
        sum = 0u; cnt = 0u; mine = 0u;
#pragma unroll
        for (unsigned j = 0; j < 16; ++j) { const unsigned c = xb_ld(&bar[XB_XCNT(j)]); sum += c; cnt += (c > 0u) ? 1u : 0u; mine = (j == x) ? c : mine; }
        if (sum == G) break;
        __builtin_amdgcn_s_sleep(1);
        if ((++sp & 255u) == 0u) { if (xb_ld(&bar[XB_TMO])) break; if (sp > XB_SPIN_CAP) { atomicAdd(&bar[XB_TMO], 1u); break; } }
    }
    nloc = mine > 0u ? mine : 1u; nx = cnt > 0u ? cnt : 1u;
}
DI void xcd_barrier(const XcdBarrier& b) {
    asm volatile("s_waitcnt vmcnt(0)" ::: "memory");
    __syncthreads();
    if (threadIdx.x == 0) {
        unsigned* bar = b.bar; asm volatile("" : "+s"(bar));
        __builtin_amdgcn_s_waitcnt(0);
        unsigned nloc = b.st[0], nx = b.st[1];
        if (nloc == 0u) { xcd_barrier_complete(bar, b.x, nloc, nx); b.st[0] = nloc; b.st[1] = nx; }
        const unsigned old = xb_add(&bar[XB_XSUB(b.x)], 1u);
        const unsigned gen = old / nloc;
        if (old + 1u == (gen + 1u) * nloc) {
            __builtin_amdgcn_fence(__ATOMIC_RELEASE, "agent");
            asm volatile("s_waitcnt vmcnt(0)" ::: "memory");
            const unsigned og = xb_add(&bar[XB_TOP], 1u);
            const unsigned tg = og / nx;
            if (og + 1u == (tg + 1u) * nx) xb_add(&bar[XB_TOPGEN], 1u);
            else XB_SPIN(xb_ld(&bar[XB_TOPGEN]) == tg, bar);
            __builtin_amdgcn_fence(__ATOMIC_ACQUIRE, "agent");
            xb_add(&bar[XB_XGEN(b.x)], 1u);
            asm volatile("s_waitcnt vmcnt(0)" ::: "memory");
        } else {
            XB_SPIN(xb_ld(&bar[XB_XGEN(b.x)]) == gen, bar);
            __builtin_amdgcn_fence(__ATOMIC_ACQUIRE, "agent");
            asm volatile("s_waitcnt vmcnt(0)" ::: "memory");
        }
    }
    __syncthreads();
}

constexpr int NS = 12;
constexpr int S_WIN = 0, S_MIX = 1, S_SCAN = 2, S_GLA3 = 3, S_MERGE = 4, S_SUM = 5, S_WO = 6, S_ROWF = 7, S_UP = 8, S_FIX = 9, S_DOWN = 10, S_ROWI = 11;
constexpr int NSTEPS = 2 + DEPTH * NS;


__global__ void __launch_bounds__(NTHR, 2) mk_fwd(Params p) {
    extern __shared__ __attribute__((aligned(16))) unsigned char lds[];
    cg::grid_group grid = cg::this_grid();
    const int ph_lo = p.ph_lo, ph_hi = p.ph_hi;
    volatile LAS unsigned* xst = (volatile LAS unsigned*)((LAS unsigned char*)lds + 131072);
    if (threadIdx.x == 0) { xst[0] = 0u; xst[1] = 0u; }
    __syncthreads();
    const XcdBarrier xbar = xcd_barrier_post((unsigned*)((unsigned char*)PIN(26) + WS_BAR), xst);
    if (ph_lo == 0 && blockIdx.x == gridDim.x - 1) phase_rope((unsigned char*)PIN(26));
#pragma unroll 1
    for (int step = ph_lo; step < ph_hi; ++step) {
        unsigned char* ws = (unsigned char*)PIN(26);
        asm volatile("" : "+s"(ws));
        bool need_sync = true;
        const float* modt = (const float*)(ws + WS_MOD);
        bf16_t* H = (bf16_t*)(ws + WS_H);
        bf16_t* M2 = (bf16_t*)(ws + WS_M2);
        bf16_t* P = (bf16_t*)(ws + WS_P);
        const int l = step < 2 ? 0 : (step - 2) / NS, s = step < 2 ? -1 : (step - 2) % NS;
        const bool last = (l == DEPTH - 1);
        const int Mr = last ? ML : MT;
        const float* modl = modt + (size_t)l * 9 * 6144;
        const bool is_gemm = (s == S_WIN) || (s == S_MERGE) || (s == S_WO) || (s == S_UP) || (s == S_DOWN);
        if (is_gemm) {
            const bf16_t* gA; const bf16_t* gB; int gM, gN, gK, glda = 1024, gldb = 1024, gasplit = 1 << 30, gaoff2 = 0;
            pg8::EpiU E{0, 0, ws};
            if (s == S_WIN) { gA = H; gB = (const bf16_t*)(ws + WS_WIN); gM = MT; gN = IN_PAD; gK = 1024; E.mode = 0; }
            else if (s == S_MERGE) {
                gA = H; gB = (const bf16_t*)(ws + WS_WBR); gldb = 512; gM = Mr; gN = 3072; gK = 512; gasplit = 4; gaoff2 = 1024; E.mode = 2; }
            else if (s == S_WO) { gA = M2; gB = (const bf16_t*)(ws + WS_WO); gM = Mr; gN = 1024; gK = 1024; E.mode = 1; E.aux = 0; }
            else if (s == S_UP) { gA = H; gB = (const bf16_t*)(ws + WS_WUP); gM = Mr; gN = UPN; gK = 1024; E.mode = 3; E.aux = l; }
            else { gA = (const bf16_t*)(ws + WS_P + PO_ACT); glda = DFF; gB = (const bf16_t*)(ws + WS_WDN); gldb = DFF; gM = Mr; gN = 1024; gK = DFF; E.mode = 1; E.aux = 1; }
            EN_GEMM(run_gemm(lds, gA, glda, gB, gldb, gM, gN, gK, E, gasplit, gaoff2);)
            if (s == S_WO && !last) { EN_CVT(phase_convert_weights(ws, l + 1, lds, 0, T0, 32);) }
            else if (s == S_DOWN && !last) { EN_CVT(phase_convert_weights(ws, l + 1, lds, T0, T5, 32);) }
            else if (s == S_MERGE && l > 0) { EN_CVT(phase_convert_weights(ws, l, lds, T5, T6, last ? 0 : 96);) }
#ifdef PROBE_GEMM_S
            if (s == PROBE_GEMM_S) { run_gemm(lds, gA, glda, gB, gldb, gM, gN, gK, E, gasplit, gaoff2); }
#endif
        } else if (step == 0) {
            EN_ADA(phase_ada(PIN(1), PIN(3), PIN(4), PIN(5), ws, lds); __syncthreads();)
#ifdef PROBE_ADA2
            phase_ada(PIN(1), PIN(3), PIN(4), PIN(5), ws, lds); __syncthreads();
#endif
            EN_CVT(phase_convert_weights(ws, 0, lds, 0, T6, 0);)
        } else if (step == 1) {
            EN_ROW(phase_rowpass(ws, MT, PIN(0), PIN(2), nullptr, nullptr, nullptr, false, true, modt, 1, 0, PIN(6));)
        } else if (s == S_MIX) {
#ifdef PROBE_MIX2
          for (int rep = 0; rep < 2; ++rep) {
#endif
            const int nA = NB * 32 * 4, nC = last ? 0 : NB * 2 * 4, nG = NCH * 4, nP = last ? 512 : NCH;
            const int ntot = nA + nC + nG + nP;
            const float* rope = (const float*)(ws + WS_ROPE);
#pragma unroll 1
            for (int it = obid(); it < ntot; it += ogrid()) {
                if (it < nA + nC) {
                    const bool isc = it >= nA; const int j = isc ? it - nA : it;
                    const int h = j & 3, blk = isc ? ((j >> 2) & 1) : ((j >> 2) & 31), b = isc ? (j >> 3) : (j >> 7);
                    EN_ATT(attn_item(P, H, PIN(11) + l * 8, rope, lds, isc, b, blk, h);)
#ifdef PROBE_ATT2
                    attn_item(P, H, PIN(11) + l * 8, rope, lds, isc, b, blk, h);
#endif
                }
                else if (it < nA + nC + nG) { const int j = it - nA - nC; EN_GLA1(gla_pass1_item(ws, PIN(14) + (size_t)l * 4096, PIN(15) + (size_t)l * 256, lds, j >> 2, j & 3);)
#ifdef PROBE_GLA12
                    gla_pass1_item(ws, PIN(14) + (size_t)l * 4096, PIN(15) + (size_t)l * 256, lds, j >> 2, j & 3);
#endif
                }
                else { const int j = it - nA - nC - nG; EN_POOL(pool_item(P, H, PIN(12) + (size_t)l * 4 * 4096, PIN(13) + (size_t)l * 256, lds, j);)
#ifdef PROBE_POOL2
                    pool_item(P, H, PIN(12) + (size_t)l * 4 * 4096, PIN(13) + (size_t)l * 256, lds, j);
#endif
                }
            }
            __syncthreads();
#ifdef PROBE_MIX2
          }
#endif
        }
        else if (s == S_SCAN) { EN_SCAN(phase_gla_scan(ws);) }
        else if (s == S_GLA3) {
            const int nch = last ? 512 : NCH;
#pragma unroll 1
            for (int it = obid(); it < nch * 4; it += ogrid()) { EN_GLA3(gla_pass3_item(ws, PIN(14) + (size_t)l * 4096, PIN(15) + (size_t)l * 256, PIN(16) + (size_t)l * 256, lds, it >> 2, it & 3);)
#ifdef PROBE_GLA32
                    gla_pass3_item(ws, PIN(14) + (size_t)l * 4096, PIN(15) + (size_t)l * 256, PIN(16) + (size_t)l * 256, lds, it >> 2, it & 3);
#endif
                }
            __syncthreads();
        }
        else if (s == S_SUM) { phase_merge_sum(P, M2, Mr); }
        else if (s == S_ROWF) {
#ifdef PROBE_ROW2
            phase_rowpass(ws, Mr, l == 0 ? PIN(0) : PIN(25), l == 0 ? PIN(2) : (const float*)(ws + WS_CTXRES), (const float*)(ws + WS_P), modl + 2 * 1024, PIN(7) + l * 1024,
                                 false, true, modl, 4, 3, PIN(8) + l * 1024);
#endif
            EN_ROW(phase_rowpass(ws, Mr, l == 0 ? PIN(0) : PIN(25), l == 0 ? PIN(2) : (const float*)(ws + WS_CTXRES), (const float*)(ws + WS_P), modl + 2 * 1024, PIN(7) + l * 1024,
                                 true, true, modl, 4, 3, PIN(8) + l * 1024);)
        }
        else if (s == S_FIX) {
            EN_CONV(phase_conv_fixup((const float*)(ws + WS_P + PO_UCH), (bf16_t*)(ws + WS_P + PO_ACT), PIN(22) + (size_t)l * 3 * UPN, PIN(23) + (size_t)l * UPN);)
        }
        else {
            EN_ROW(phase_rowpass(ws, Mr, PIN(25), (const float*)(ws + WS_CTXRES), (const float*)(ws + WS_P + PO_Y2), modl + 5 * 1024, PIN(9) + l * 1024,
                          true, !last, modl + 9 * 6144, 1, 0, PIN(6) + (last ? 0 : (l + 1) * 1024));)
        }
        if (need_sync && step + 1 < ph_hi) {
            if (ph_lo < 0) grid.sync();
            xcd_barrier(xbar);
        }
#ifdef PROBE_SYNC2
        xcd_barrier(xbar); xcd_barrier(xbar);
#endif
    }
}

extern "C" void kernel_launch(void* const* d_in, const int* in_sizes, int n_in, void* d_out, int out_size, void* d_ws, size_t ws_size, hipStream_t stream) {
    static int grid = 0;
    if (!grid) {
        int dev = 0, cus = 0, per_cu = 0;
        (void)hipGetDevice(&dev);
        (void)hipDeviceGetAttribute(&cus, hipDeviceAttributeMultiprocessorCount, dev);
        (void)hipFuncSetAttribute((const void*)mk_fwd, hipFuncAttributeMaxDynamicSharedMemorySize, LDS_BYTES);
        (void)hipOccupancyMaxActiveBlocksPerMultiprocessor(&per_cu, (const void*)mk_fwd, NTHR, LDS_BYTES);
        if (per_cu < 1) per_cu = 1;
        grid = cus * per_cu;
        if (ws_size < WS_END || n_in != 25) { fprintf(stderr, "kernel_launch: ws %zu < %zu or n_in %d\n", ws_size, (size_t)WS_END, n_in); }
    }
    (void)hipMemsetAsync((unsigned char*)d_ws + WS_BAR, 0, 16384, stream);
    Params p{};
    for (int i = 0; i < 25; ++i) p.in[i] = (const float*)d_in[i];
    p.out = (float*)d_out; p.ws = (unsigned char*)d_ws; p.ph_lo = 0; p.ph_hi = NSTEPS;
    void* args[] = {&p};
    hipError_t e = hipLaunchCooperativeKernel((const void*)mk_fwd, dim3(grid), dim3(NTHR), args, LDS_BYTES, stream);
    if (e != hipSuccess) fprintf(stderr, "cooperative launch failed: %s (grid %d)\n", hipGetErrorString(e), grid);
}
```

```cpp
#include <hip/hip_runtime.h>
#include <hip/hip_cooperative_groups.h>
#include <cstdio>
namespace cg = cooperative_groups;

#ifndef DIS_GEMM
#define EN_GEMM(...) __VA_ARGS__
#else
#define EN_GEMM(...)
#endif
#ifndef DIS_ADA
#define EN_ADA(...) __VA_ARGS__
#else
#define EN_ADA(...)
#endif
#ifndef DIS_CVT
#define EN_CVT(...) __VA_ARGS__
#else
#define EN_CVT(...)
#endif
#ifndef DIS_ROW
#define EN_ROW(...) __VA_ARGS__
#else
#define EN_ROW(...)
#endif
#ifndef DIS_G1
#define EN_G1(...) __VA_ARGS__
#else
#define EN_G1(...)
#endif
#ifndef DIS_ATT
#define EN_ATT(...) __VA_ARGS__
#else
#define EN_ATT(...)
#endif
#ifndef DIS_GLA1
#define EN_GLA1(...) __VA_ARGS__
#else
#define EN_GLA1(...)
#endif
#ifndef DIS_POOL
#define EN_POOL(...) __VA_ARGS__
#else
#define EN_POOL(...)
#endif
#ifndef DIS_SCAN
#define EN_SCAN(...) __VA_ARGS__
#else
#define EN_SCAN(...)
#endif
#ifndef DIS_GLA3
#define EN_GLA3(...) __VA_ARGS__
#else
#define EN_GLA3(...)
#endif
#ifndef DIS_GM
#define EN_GM(...) __VA_ARGS__
#else
#define EN_GM(...)
#endif
#ifndef DIS_GO
#define EN_GO(...) __VA_ARGS__
#else
#define EN_GO(...)
#endif
#ifndef DIS_GU
#define EN_GU(...) __VA_ARGS__
#else
#define EN_GU(...)
#endif
#ifndef DIS_CONV
#define EN_CONV(...) __VA_ARGS__
#else
#define EN_CONV(...)
#endif
#ifndef DIS_GD
#define EN_GD(...) __VA_ARGS__
#else
#define EN_GD(...)
#endif
#define LAS __attribute__((address_space(3)))
#define DI __device__ __forceinline__
typedef unsigned short bf16_t;
typedef short bf16x8 __attribute__((ext_vector_type(8)));
typedef short s16x4 __attribute__((ext_vector_type(4)));
typedef float f32x4 __attribute__((ext_vector_type(4)));
typedef float f32x2 __attribute__((ext_vector_type(2)));
typedef unsigned u32x4 __attribute__((ext_vector_type(4)));
typedef unsigned u32x2 __attribute__((ext_vector_type(2)));

constexpr int DM = 1024, NB = 8, SEQ = 4096, DEPTH = 4, CTXL = 256;
constexpr int ML = NB * SEQ, MC = NB * CTXL, MT = ML + MC;
constexpr int IN_DIM = 4896, IN_PAD = 5120, DFF = 2816, UPN = 5632;
constexpr int C_AQ = 0, C_AK = 512, C_AV = 640, C_PU = 768, C_GQ = 1024, C_GK = 1152, C_GV = 1280, C_GR = 1536, C_GLR = 1792, C_MG = 1824;
constexpr int NCH = MT / 64;
constexpr float EPS = 1e-6f;
constexpr int NTHR = 512;
constexpr int LDS_BYTES = 131072 + 64 + 8192 + 4096;

constexpr size_t WS_CTXRES = 0;
constexpr size_t WS_MOD = WS_CTXRES + (size_t)MC * DM * 4;
constexpr size_t WS_ROPE = WS_MOD + (size_t)DEPTH * 9 * 6144 * 4;
constexpr size_t WS_GDEC = WS_ROPE + 64 * 16 * 2 * 4;
constexpr size_t WS_WIN = WS_GDEC + (size_t)NCH * 4 * 2 * 32 * 4;
constexpr size_t WS_WBR = WS_WIN + (size_t)IN_PAD * 1024 * 2;
constexpr size_t WS_WO = WS_WBR + (size_t)3072 * 512 * 2;
constexpr size_t WS_WUP = WS_WO + (size_t)1024 * 1024 * 2;
constexpr size_t WS_WDN = WS_WUP + (size_t)UPN * 1024 * 2;
constexpr size_t WS_H = WS_WDN + (size_t)1024 * DFF * 2;
constexpr size_t WS_M2 = WS_H + (size_t)MT * 1024 * 2;
constexpr size_t WS_P = WS_M2 + (size_t)MT * 1024 * 2;
constexpr size_t WS_BAR = WS_P + (size_t)MT * IN_DIM * 2;
constexpr size_t WS_END = WS_BAR + 16384;
constexpr size_t PO_ACT = 0;
constexpr size_t PO_UCH = (size_t)MT * DFF * 2;
constexpr size_t PO_Y2 = PO_UCH;
static_assert(PO_Y2 + (size_t)MT * 1024 * 4 <= (size_t)MT * IN_DIM * 2, "P region too small");
static_assert(PO_UCH + (size_t)10240 * UPN * 2 <= (size_t)MT * IN_DIM * 2, "P region too small");

struct Params { const float* in[25]; float* out; unsigned char* ws; int ph_lo, ph_hi; };
typedef const float* const volatile __attribute__((address_space(4))) * KargTbl;
#define PIN(i) (((KargTbl)__builtin_amdgcn_kernarg_segment_ptr())[i])

DI float bf2f(bf16_t b) { return __uint_as_float(((unsigned)b) << 16); }
DI bf16_t f2bf(float f) { unsigned u = __float_as_uint(f); u += 0x7FFFu + ((u >> 16) & 1u); return (bf16_t)(u >> 16); }
DI unsigned pk_bf16(float lo, float hi) { unsigned r; asm("v_cvt_pk_bf16_f32 %0, %1, %2" : "=v"(r) : "v"(lo), "v"(hi)); return r; }
typedef __bf16 bf16x2v __attribute__((ext_vector_type(2)));
DI unsigned pk_bf16_mfma(float lo, float hi) { const f32x2 v = {lo, hi}; return __builtin_bit_cast(unsigned, __builtin_convertvector(v, bf16x2v)); }
DI float lo_f(unsigned w) { return __uint_as_float(w << 16); }
DI float hi_f(unsigned w) { return __uint_as_float(w & 0xffff0000u); }
DI float sigmoidf_(float x) { return __builtin_amdgcn_rcpf(1.f + __expf(-x)); }
DI float siluf_(float x) { return x * __builtin_amdgcn_rcpf(1.f + __expf(-x)); }
DI int obid() { int t = blockIdx.x; asm volatile("" : "+s"(t)); return t; }
DI int ogrid() { int t = gridDim.x; asm volatile("" : "+s"(t)); return t; }
DI int otid() { int t = threadIdx.x; asm volatile("" : "+v"(t)); return t; }
DI float shx(float v, int m, int lane) { return __int_as_float(__builtin_amdgcn_ds_bpermute((lane ^ m) << 2, __float_as_int(v))); }
DI float wave_sum(float v) {
    const int lane = otid() & 63;
#pragma unroll
    for (int o = 32; o >= 1; o >>= 1) v += shx(v, o, lane);
    return v;
}

namespace pg8 {
constexpr int BM = 256, BK = 64, HALF = 128, HTB = HALF * BK * 2, STAGE_BYTES = 8 * HTB, NXCD = 8, WGM = 8;
DI int lds_byte(int r, int c) { const int st = (r >> 4) * 2 + (c >> 5), rr = r & 15, cc = c & 31, ob = rr * 64 + cc * 2; return st * 1024 + (ob ^ (((ob >> 9) & 1) << 5)); }
DI void stage_rc(int b, int& R, int& C) { const int st = b / 1024, sb = b % 1024, swz = sb ^ (((sb >> 9) & 1) << 5); R = (st >> 1) * 16 + swz / 64; C = (st & 1) * 32 + (swz % 64) / 2; }
DI int perm32(int rho) { const int n = rho >> 4, i = rho & 15; return 8 * (i >> 2) + 4 * n + (i & 3); }
struct Unit { int pm, pn; };
struct Gemm { const bf16_t* A; const bf16_t* Bt; int M, N, K, lda, ldb, asplit, aoff2; };
struct StaticOrder {
    int nM, nN, nwg, G, c;
    DI void init(int M, int N, int G_, int c_) { nM = M / BM; nN = N / BM; nwg = nM * nN; G = G_; c = c_; }
    DI bool next(int i, Unit& u) const {
        const long L = (long)i * G + c; if (L >= nwg) return false;
        int wgid = (int)L; { const int q = nwg / NXCD, r = nwg % NXCD, xcd = wgid % NXCD, off = wgid / NXCD; wgid = (xcd < r ? xcd * (q + 1) : r * (q + 1) + (xcd - r) * q) + off; }
        const int nig = WGM * nN, gid = wgid / nig, fm = gid * WGM, gsz = (nM - fm) < WGM ? (nM - fm) : WGM;
        u.pm = fm + ((wgid % nig) % gsz); u.pn = (wgid % nig) / gsz; return true;
    }
};

template <class Epi>
DI void gemm_phase(LAS unsigned char* lds, const Gemm g, const StaticOrder& S, const Epi& E) {
    const int tid = otid(), wid = __builtin_amdgcn_readfirstlane(tid >> 6), lane = tid & 63, wr = wid >> 2, wc = wid & 3, fr = lane & 15, fq = lane >> 4;
    const int K = g.K, nt = K / BK;
    unsigned voffA[2], voffB[2];
#pragma unroll
    for (int i = 0; i < 2; ++i) { int R, C; stage_rc(tid * 16 + i * 8192, R, C); const int Rb = Epi::PERM ? ((R & ~31) + perm32(R & 31)) : R;
        voffA[i] = (unsigned)(R * g.lda + C) * 2u; voffB[i] = (unsigned)(Rb * g.ldb + C) * 2u; }
    const size_t kstep = (size_t)(BK * 2);
    const size_t hstepA = (size_t)HALF * g.lda * 2, hstepB = (size_t)HALF * g.ldb * 2;
    const size_t tstepA = 2 * hstepA, tstepB = 2 * hstepB;
    const unsigned ldsw = (unsigned)wid * 1024u;
    const int aoff = lds_byte(wr * 64 + fr, fq * 8), boff = lds_byte(wc * 32 + fr, fq * 8);
#define PG8_SA(b, h) (((b) * 2 + (h)) * HTB)
#define PG8_SB(b, h) ((4 + (b) * 2 + (h)) * HTB)
#define PG8_STAGE(bufoff, gbase, voff) do { _Pragma("unroll") for (int _i = 0; _i < 2; ++_i) \
        __builtin_amdgcn_global_load_lds((const unsigned*)((const char*)(gbase) + (voff)[_i]), (LAS unsigned*)(lds + (bufoff) + ldsw + _i * 8192), 16, 0, 0); } while (0)
#define PG8_LDA(dst, b, h) do { _Pragma("unroll") for (int m = 0; m < 4; ++m) _Pragma("unroll") for (int k = 0; k < 2; ++k) dst[m][k] = *(const LAS bf16x8*)(lds + PG8_SA(b, h) + aoff + m * 2048 + k * 1024); } while (0)
#define PG8_LDB(dst, b, h) do { _Pragma("unroll") for (int n = 0; n < 2; ++n) _Pragma("unroll") for (int k = 0; k < 2; ++k) dst[n][k] = *(const LAS bf16x8*)(lds + PG8_SB(b, h) + boff + n * 2048 + k * 1024); } while (0)
#define PG8_MMA(ai, bj, At, Bt) do { __builtin_amdgcn_s_setprio(1); _Pragma("unroll") for (int m = 0; m < 4; ++m) _Pragma("unroll") for (int n = 0; n < 2; ++n) _Pragma("unroll") for (int k = 0; k < 2; ++k) \
        acc[ai][bj][m][n] = __builtin_amdgcn_mfma_f32_16x16x32_bf16(Bt[n][k], At[m][k], acc[ai][bj][m][n], 0, 0, 0); __builtin_amdgcn_s_setprio(0); } while (0)
#define PG8_WAIT_V(n) asm volatile("s_waitcnt vmcnt(" #n ")" ::: "memory")
#define PG8_WAIT_L(n) asm volatile("s_waitcnt lgkmcnt(" #n ")" ::: "memory")
#define PG8_BAR __builtin_amdgcn_s_barrier()
#define PG8_SCHED __builtin_amdgcn_sched_barrier(0)
    Unit cur, nxt; int ui = 0;
    if (!S.next(0, cur)) return;
    f32x4 acc[2][2][4][2];
#pragma unroll
    for (int a = 0; a < 2; ++a)
#pragma unroll
        for (int b = 0; b < 2; ++b)
#pragma unroll
            for (int m = 0; m < 4; ++m)
#pragma unroll
                for (int n = 0; n < 2; ++n) acc[a][b][m][n] = (f32x4){0.f, 0.f, 0.f, 0.f};
    bf16x8 At[4][2], B0[2][2], B1[2][2];
    const bool mrg = (g.asplit == 4);
#define PG8_AOFS(u) (mrg ? ((u).pn >= 8 ? 1536 : ((u).pn >= 4 ? 1024 : 0)) : 0)
#define PG8_BOFS(u) ((mrg && (u).pn >= 8) ? 512 : 0)
#define PG8_NT(u) ((mrg && (u).pn >= 4) ? 4 : nt)
    const char* cA = (const char*)g.A + (size_t)cur.pm * tstepA + PG8_AOFS(cur); const char* cB = (const char*)g.Bt + (size_t)cur.pn * tstepB + PG8_BOFS(cur);
    PG8_STAGE(PG8_SB(0, 0), cB, voffB); PG8_STAGE(PG8_SA(0, 0), cA, voffA); PG8_STAGE(PG8_SB(0, 1), cB + hstepB, voffB); PG8_STAGE(PG8_SA(0, 1), cA + hstepA, voffA);
    if (wr == 1) PG8_BAR;
    PG8_WAIT_V(4); PG8_BAR;
    PG8_STAGE(PG8_SB(1, 0), cB + kstep, voffB); PG8_STAGE(PG8_SA(1, 0), cA + kstep, voffA); PG8_STAGE(PG8_SB(1, 1), cB + hstepB + kstep, voffB);
    PG8_WAIT_V(6); PG8_BAR;
    for (;;) {
        const bool has_next = S.next(ui + 1, nxt);
        const char* nA = has_next ? (const char*)g.A + (size_t)nxt.pm * tstepA + PG8_AOFS(nxt) : cA; const char* nB = has_next ? (const char*)g.Bt + (size_t)nxt.pn * tstepB + PG8_BOFS(nxt) : cB;
        const int ntc = PG8_NT(cur);
        for (int t = 0; t < ntc; t += 2) {
            const bool last = (t == ntc - 2);
            const char* a1 = cA + (size_t)(t + 1) * kstep;
            const char* a2 = last ? nA : cA + (size_t)(t + 2) * kstep; const char* b2 = last ? nB : cB + (size_t)(t + 2) * kstep;
            const char* a3 = a2 + kstep; const char* b3 = b2 + kstep;
            PG8_LDB(B0, 0, 0); PG8_SCHED; PG8_LDA(At, 0, 0); PG8_STAGE(PG8_SA(1, 1), a1 + hstepA, voffA);
            PG8_WAIT_L(8); PG8_BAR; PG8_WAIT_L(0); PG8_MMA(0, 0, At, B0); PG8_BAR; PG8_SCHED;
            PG8_LDB(B1, 0, 1); PG8_STAGE(PG8_SB(0, 0), b2, voffB);
            PG8_BAR; PG8_WAIT_L(0); PG8_MMA(0, 1, At, B1); PG8_BAR;
            PG8_LDA(At, 0, 1); PG8_STAGE(PG8_SA(0, 0), a2, voffA);
            PG8_BAR; PG8_WAIT_L(0); PG8_MMA(1, 0, At, B0); PG8_BAR; PG8_SCHED;
            PG8_STAGE(PG8_SB(0, 1), b2 + hstepB, voffB);
            PG8_WAIT_V(6); PG8_BAR; PG8_MMA(1, 1, At, B1); PG8_BAR;
            PG8_LDB(B0, 1, 0); PG8_SCHED; PG8_LDA(At, 1, 0); PG8_STAGE(PG8_SA(0, 1), a2 + hstepA, voffA);
            PG8_WAIT_L(8); PG8_BAR; PG8_WAIT_L(0); PG8_MMA(0, 0, At, B0); PG8_BAR; PG8_SCHED;
            PG8_LDB(B1, 1, 1); PG8_STAGE(PG8_SB(1, 0), b3, voffB);
            PG8_BAR; PG8_WAIT_L(0); PG8_MMA(0, 1, At, B1); PG8_BAR;
            PG8_LDA(At, 1, 1); PG8_STAGE(PG8_SA(1, 0), a3, voffA);
            PG8_BAR; PG8_WAIT_L(0); PG8_MMA(1, 0, At, B0); PG8_BAR; PG8_SCHED;
            PG8_STAGE(PG8_SB(1, 1), b3 + hstepB, voffB);
            PG8_WAIT_V(6); PG8_BAR; PG8_MMA(1, 1, At, B1); PG8_BAR;
        }
        {
            int wr2 = wr, wc2 = wc; Unit cu2 = cur; Epi E2 = E;
            asm volatile("" : "+s"(wr2), "+s"(wc2), "+s"(cu2.pm), "+s"(cu2.pn), "+s"(E2.ws), "+s"(E2.aux));
            const int ln2 = otid() & 63;
            const int fr2 = ln2 & 15, fq2 = ln2 >> 4;
            E2(acc, cu2, wr2, wc2, fr2, fq2, lds);
        }
        if (!has_next) break;
#pragma unroll
        for (int a = 0; a < 2; ++a)
#pragma unroll
            for (int b = 0; b < 2; ++b)
#pragma unroll
                for (int m = 0; m < 4; ++m)
#pragma unroll
                    for (int n = 0; n < 2; ++n) acc[a][b][m][n] = (f32x4){0.f, 0.f, 0.f, 0.f};
        cur = nxt; cA = nA; cB = nB; ++ui;
    }
    PG8_WAIT_V(0);
    if (wr == 0) PG8_BAR;
    PG8_BAR;
#undef PG8_AOFS
#undef PG8_BOFS
#undef PG8_NT
#undef PG8_SA
#undef PG8_SB
#undef PG8_STAGE
#undef PG8_LDA
#undef PG8_LDB
#undef PG8_MMA
#undef PG8_WAIT_V
#undef PG8_WAIT_L
#undef PG8_BAR
#undef PG8_SCHED
}

struct EpiU {
    static constexpr bool PERM = true;
    int mode; int aux; unsigned char* ws;
    DI void operator()(const f32x4 (&acc)[2][2][4][2], const Unit& u, int wr, int wc, int fr, int fq, LAS unsigned char* lds) const {
        void* const out = (mode == 0) ? (void*)(ws + WS_P) : (mode == 1) ? (void*)(ws + WS_P + (aux ? PO_Y2 : 0)) : (mode == 2) ? (void*)(ws + WS_M2) : (void*)(ws + WS_P + PO_ACT);
        const int ldc = (mode == 0) ? IN_DIM : 1024, ncols = IN_DIM, br = aux;
        const bf16_t* const P = (const bf16_t*)(ws + WS_P);
        const float* const cw = PIN(22) + (size_t)aux * 3 * UPN; const float* const cb = PIN(23) + (size_t)aux * UPN;
        float* const edge = (float*)(ws + WS_P + PO_UCH);
        const int row0 = u.pm * BM + wr * 64 + fr, col0 = u.pn * BM + wc * 32 + 8 * fq;
        const unsigned rl0 = (unsigned)(wr * 64 + fr), cl0 = (unsigned)(wc * 32 + 8 * fq);
        if (mode == 0) {
            bf16_t* Ob = (bf16_t*)out + (size_t)u.pm * BM * ldc + u.pn * BM;
#pragma unroll
            for (int ai = 0; ai < 2; ++ai)
#pragma unroll
                for (int m = 0; m < 4; ++m)
#pragma unroll
                    for (int bj = 0; bj < 2; ++bj) { const int col = col0 + bj * HALF;
                        const f32x4 v0 = acc[ai][bj][m][0], v1 = acc[ai][bj][m][1];
                        u32x4 o; o[0] = pk_bf16_mfma(v0[0], v0[1]); o[1] = pk_bf16_mfma(v0[2], v0[3]); o[2] = pk_bf16_mfma(v1[0], v1[1]); o[3] = pk_bf16_mfma(v1[2], v1[3]);
                        if (col < ncols) *(u32x4*)(Ob + ((rl0 + ai * HALF + m * 16) * (unsigned)IN_DIM + cl0 + bj * HALF)) = o; }
        } else if (mode == 1) {
            float* Cb = (float*)out + (size_t)u.pm * BM * 1024 + u.pn * BM;
#pragma unroll
            for (int ai = 0; ai < 2; ++ai)
#pragma unroll
                for (int m = 0; m < 4; ++m)
#pragma unroll
                    for (int bj = 0; bj < 2; ++bj) { float* rp = Cb + ((rl0 + ai * HALF + m * 16) * 1024u + cl0 + bj * HALF);
                        *(f32x4*)rp = acc[ai][bj][m][0]; *(f32x4*)(rp + 4) = acc[ai][bj][m][1]; }
        } else if (mode == 3) {
            bf16_t* ACTb = (bf16_t*)out + (size_t)u.pm * 256 * DFF + u.pn * 128;
            LAS float* XR = (LAS float*)(lds + 131072 + 64);
            LAS float* CWL = XR + 2048;
            const int lane = (fq << 4) | fr;
            const int cl = wc * 32 + 8 * fq;
            if (fr == 0) {
#pragma unroll
                for (int ai = 0; ai < 2; ++ai)
#pragma unroll
                    for (int bj = 0; bj < 2; ++bj)
#pragma unroll
                        for (int n = 0; n < 2; ++n) *(LAS f32x4*)(XR + ((((wr * 2 + ai) * 2 + 0) * 2 + bj) * 128 + cl + 4 * n)) = acc[ai][bj][0][n];
            }
            if (fr == 15) {
#pragma unroll
                for (int ai = 0; ai < 2; ++ai)
#pragma unroll
                    for (int bj = 0; bj < 2; ++bj)
#pragma unroll
                        for (int n = 0; n < 2; ++n) *(LAS f32x4*)(XR + ((((wr * 2 + ai) * 2 + 1) * 2 + bj) * 128 + cl + 4 * n)) = acc[ai][bj][3][n];
            }
            {
                float* EGb = edge + (size_t)u.pm * 4 * UPN + u.pn * 256;
                if (wr == 0 && fr < 2) {
#pragma unroll
                    for (int bj = 0; bj < 2; ++bj)
#pragma unroll
                        for (int n = 0; n < 2; ++n) *(f32x4*)(EGb + (unsigned)(fr * UPN + cl + bj * 128 + 4 * n)) = acc[0][bj][0][n];
                }
                if (wr == 1 && fr >= 14) {
#pragma unroll
                    for (int bj = 0; bj < 2; ++bj)
#pragma unroll
                        for (int n = 0; n < 2; ++n) *(f32x4*)(EGb + (unsigned)((fr - 12) * UPN + cl + bj * 128 + 4 * n)) = acc[1][bj][3][n];
                }
            }
            {
                const int tid = (((wr << 2) | wc) << 6) | lane;
#pragma unroll
                for (int i = 0; i < 2; ++i) {
                    const int idx = tid + 512 * i, pp = idx >> 7, c = idx & 127;
                    const int srcc = ((pp >= 4) ? DFF : 0) + u.pn * 128 + c;
                    CWL[idx] = ((pp & 3) == 3) ? cb[srcc] : cw[(pp & 3) * UPN + srcc];
                }
            }
            asm volatile("s_waitcnt vmcnt(0) lgkmcnt(0)" ::: "memory");
            __builtin_amdgcn_s_barrier(); __builtin_amdgcn_s_barrier();
            asm volatile("" ::: "memory");
#pragma unroll
            for (int ai = 0; ai < 2; ++ai) {
                const bool hasp = !(wr == 0 && ai == 0), hasn = !(wr == 1 && ai == 1);
                const int pw = (wr == 1) ? 0 : 1, pa = (wr == 1) ? ai : 0;
                const int nw = (wr == 0) ? 1 : 0, na = (wr == 0) ? ai : 1;
                const LAS float* xp = XR + ((((pw * 2 + pa) * 2 + 1) * 2 + 0) * 128 + cl);
                const LAS float* xn = XR + ((((nw * 2 + na) * 2 + 0) * 2 + 0) * 128 + cl);
#pragma unroll
                for (int n = 0; n < 2; ++n) {
                    float o[4][4];
#pragma unroll
                    for (int e = 0; e < 4; ++e) {
                        const LAS float* cwp = CWL + cl + 4 * n + e;
                        const float xpa = hasp ? xp[4 * n + e] : 0.f, xpg = hasp ? xp[128 + 4 * n + e] : 0.f;
                        const float xna = hasn ? xn[4 * n + e] : 0.f, xng = hasn ? xn[128 + 4 * n + e] : 0.f;
                        float ap[4], gp[4], an[4], gn[4];
#pragma unroll
                        for (int m = 0; m < 4; ++m) {
                            const float ca = acc[ai][0][m][n][e], cg2 = acc[ai][1][m][n][e];
                            const float oa_p = (fr == 15) ? acc[ai][0][m == 0 ? 0 : m - 1][n][e] : ca, og_p = (fr == 15) ? acc[ai][1][m == 0 ? 0 : m - 1][n][e] : cg2;
                            const float oa_n = (fr == 0) ? acc[ai][0][m == 3 ? 3 : m + 1][n][e] : ca, og_n = (fr == 0) ? acc[ai][1][m == 3 ? 3 : m + 1][n][e] : cg2;
                            ap[m] = __int_as_float(__builtin_amdgcn_mov_dpp(__float_as_int(oa_p), 0x121, 0xF, 0xF, false));
                            gp[m] = __int_as_float(__builtin_amdgcn_mov_dpp(__float_as_int(og_p), 0x121, 0xF, 0xF, false));
                            an[m] = __int_as_float(__builtin_amdgcn_mov_dpp(__float_as_int(oa_n), 0x12F, 0xF, 0xF, false));
                            gn[m] = __int_as_float(__builtin_amdgcn_mov_dpp(__float_as_int(og_n), 0x12F, 0xF, 0xF, false));
                        }
                        ap[0] = (fr == 0) ? xpa : ap[0]; gp[0] = (fr == 0) ? xpg : gp[0];
                        an[3] = (fr == 15) ? xna : an[3]; gn[3] = (fr == 15) ? xng : gn[3];
                        const float w0a = cwp[0], w1a = cwp[128], w2a = cwp[256], bba = cwp[384];
                        const float w0g = cwp[512], w1g = cwp[640], w2g = cwp[768], bbg = cwp[896];
#pragma unroll
                        for (int m = 0; m < 4; ++m) {
                            const float av = w0a * ap[m] + w1a * acc[ai][0][m][n][e] + w2a * an[m] + bba;
                            const float gv = w0g * gp[m] + w1g * acc[ai][1][m][n][e] + w2g * gn[m] + bbg;
                            o[m][e] = av * siluf_(gv);
                        }
                        __builtin_amdgcn_sched_barrier(0);
                    }
#pragma unroll
                    for (int m = 0; m < 4; ++m) {
                        u32x2 ov; ov[0] = pk_bf16(o[m][0], o[m][1]); ov[1] = pk_bf16(o[m][2], o[m][3]);
                        *(u32x2*)(ACTb + (unsigned)((wr * 64 + fr + ai * HALF + m * 16) * DFF + cl + 4 * n)) = ov;
                    }
                    __builtin_amdgcn_sched_barrier(0);
                }
            }
        } else {
            bf16_t* Gb = (bf16_t*)(ws + WS_P) + C_MG + (size_t)u.pm * BM * IN_DIM + u.pn * BM;
#pragma unroll
            for (int ai = 0; ai < 2; ++ai)
#pragma unroll
                for (int m = 0; m < 4; ++m)
#pragma unroll
                    for (int bj = 0; bj < 2; ++bj) {
                        bf16_t* gp = Gb + ((rl0 + ai * HALF + m * 16) * (unsigned)IN_DIM + cl0 + bj * HALF);
                        const u32x4 gv = *(const u32x4*)gp;
                        const f32x4 v0 = acc[ai][bj][m][0], v1 = acc[ai][bj][m][1];
                        u32x4 o;
                        o[0] = pk_bf16(v0[0] * sigmoidf_(lo_f(gv[0])), v0[1] * sigmoidf_(hi_f(gv[0]))); o[1] = pk_bf16(v0[2] * sigmoidf_(lo_f(gv[1])), v0[3] * sigmoidf_(hi_f(gv[1])));
                        o[2] = pk_bf16(v1[0] * sigmoidf_(lo_f(gv[2])), v1[1] * sigmoidf_(hi_f(gv[2]))); o[3] = pk_bf16(v1[2] * sigmoidf_(lo_f(gv[3])), v1[3] * sigmoidf_(hi_f(gv[3])));
                        *(u32x4*)gp = o; }
        }
    }
};
}

template <class Epi>
DI void run_gemm(unsigned char* lds, const bf16_t* A, int lda, const bf16_t* Bt, int ldb, int M, int N, int K, const Epi& E, int asplit = 1 << 30, int aoff2 = 0) {
    pg8::Gemm g{A, Bt, M, N, K, lda, ldb, asplit, aoff2};
    pg8::StaticOrder S; S.init(M, N, ogrid(), obid());
    pg8::gemm_phase<Epi>((LAS unsigned char*)lds, g, S, E);
}

DI void sincos_acc(float x, float& c, float& s) {
    const double xd = (double)x;
    const double kd = __builtin_rint(xd * 0.63661977236758134308);
    double r = __builtin_fma(-kd, 1.57079632679489655800, xd);
    r = __builtin_fma(-kd, 6.12323399573676603587e-17, r);
    const double r2 = r * r;
    const double sp = r * (1.0 + r2 * (-1.0 / 6 + r2 * (1.0 / 120 + r2 * (-1.0 / 5040 + r2 * (1.0 / 362880 + r2 * (-1.0 / 39916800 + r2 * (1.0 / 6227020800.0)))))));
    const double cp = 1.0 + r2 * (-0.5 + r2 * (1.0 / 24 + r2 * (-1.0 / 720 + r2 * (1.0 / 40320 + r2 * (-1.0 / 3628800 + r2 * (1.0 / 479001600.0 + r2 * (-1.0 / 87178291200.0)))))));
    const int k = ((int)kd) & 3;
    const double cc = (k == 0) ? cp : (k == 1) ? -sp : (k == 2) ? -cp : sp;
    const double ss = (k == 0) ? sp : (k == 1) ? cp : (k == 2) ? -sp : -cp;
    c = (float)cc; s = (float)ss;
}

DI void phase_rope(unsigned char* ws) {
    const int tid = otid();
    {
        float* rt = (float*)(ws + WS_ROPE);
        for (int i = tid; i < 1024; i += NTHR) {
            const int pos = i >> 4, fi = i & 15;
            const double b4 = ((fi & 3) == 0) ? 1.0 : ((fi & 3) == 1) ? 0.56234132519034908 : ((fi & 3) == 2) ? 0.31622776601683794 : 0.17782794100389228;
            const double p10 = ((fi >> 2) == 0) ? 1.0 : ((fi >> 2) == 1) ? 0.1 : ((fi >> 2) == 2) ? 0.01 : 0.001;
            const float inv = (float)(b4 * p10);
            const float ang = (float)pos * inv;
            float c, s; sincos_acc(ang, c, s);
            rt[2 * i] = c; rt[2 * i + 1] = s;
        }
    }
}

DI const float* p_wada(const float* w_ada, int l) { return w_ada + (size_t)l * 1024 * 6144; }
DI void phase_ada(const float* c_in, const float* cctx_in, const float* w_ada, const float* b_ada, unsigned char* ws, unsigned char* lds) {
    float* sc = (float*)lds;
    float* red = sc + 9 * 1024;
    const int tid = otid();
    float* modt = (float*)(ws + WS_MOD);
    for (int i = tid; i < 9 * 1024; i += NTHR) { const int r = i >> 10, k = i & 1023; const float v = r < 8 ? c_in[r * 1024 + k] : cctx_in[k]; sc[i] = siluf_(v); }
    __syncthreads();
    for (int it = obid(); it < DEPTH * 48; it += ogrid()) {
        const int l = it / 48, cgp = it % 48;
        const int c4 = (tid & 31) * 4, kg = tid >> 5;
        const float* W = p_wada(w_ada, l) + cgp * 128 + c4;
        float acc[9][4];
#pragma unroll
        for (int r = 0; r < 9; ++r)
#pragma unroll
            for (int j = 0; j < 4; ++j) acc[r][j] = 0.f;
#pragma unroll 8
        for (int k = kg * 64; k < kg * 64 + 64; ++k) {
            const f32x4 w = __builtin_nontemporal_load((const f32x4*)(W + (size_t)k * 6144));
#pragma unroll
            for (int r = 0; r < 9; ++r) { const float sv = sc[r * 1024 + k]; acc[r][0] += sv * w[0]; acc[r][1] += sv * w[1]; acc[r][2] += sv * w[2]; acc[r][3] += sv * w[3]; }
        }
#pragma unroll
        for (int r = 0; r < 9; ++r)
#pragma unroll
            for (int j = 0; j < 4; ++j) red[(kg * 128 + c4 + j) * 9 + r] = acc[r][j];
        __syncthreads();
        if (tid < 128) {
            const int col = cgp * 128 + tid;
            const float bb = b_ada[l * 6144 + col];
#pragma unroll
            for (int r = 0; r < 9; ++r) {
                float s = 0.f;
#pragma unroll
                for (int g = 0; g < 16; ++g) s += red[(g * 128 + tid) * 9 + r];
                modt[((size_t)l * 9 + r) * 6144 + col] = s + bb;
            }
        }
        __syncthreads();
    }
}

DI void tr_tile(const float* src, int src_ld, int k0, int n0, int mode, bf16_t* dst, int dst_ld, int dst_koff, float* tile) {
    const int tid = otid();
    {   const int nn4 = (tid & 15) * 4; const int np = n0 + nn4;
        int col = np; bool valid = true;
        if (mode == 1) valid = np < IN_DIM;
        if (mode == 3) valid = false;
        if (mode == 2) { const int pn = np >> 8, bj = (np >> 7) & 1, jj = np & 127; col = bj * DFF + pn * 128 + jj; }
#pragma unroll
        for (int i = 0; i < 2; ++i) { const int kk = (tid >> 4) + 32 * i;
            f32x4 v = (f32x4){0.f, 0.f, 0.f, 0.f};
            if (valid) v = __builtin_nontemporal_load((const f32x4*)(src + (size_t)(k0 + kk) * src_ld + col));
            tile[kk * 65 + nn4] = v[0]; tile[kk * 65 + nn4 + 1] = v[1]; tile[kk * 65 + nn4 + 2] = v[2]; tile[kk * 65 + nn4 + 3] = v[3]; }
    }
    __syncthreads();
    {   const int nn = tid >> 3, ks = (tid & 7) * 8;
        float v[8];
#pragma unroll
        for (int j = 0; j < 8; ++j) v[j] = tile[(ks + j) * 65 + nn];
        u32x4 o; o[0] = pk_bf16(v[0], v[1]); o[1] = pk_bf16(v[2], v[3]); o[2] = pk_bf16(v[4], v[5]); o[3] = pk_bf16(v[6], v[7]);
        *(u32x4*)(dst + (size_t)(n0 + nn) * dst_ld + dst_koff + k0 + ks) = o;
    }
    __syncthreads();
}

constexpr int T0 = 1280, T1 = T0 + 128, T2 = T1 + 64, T2b = T2 + 64, T2c = T2b + 64, T3 = T2c + 64, T4 = T3 + 256, T5 = T4 + 1408, T6 = T5 + 704;
DI void phase_convert_weights(unsigned char* ws, int l, unsigned char* lds, int t_lo, int t_hi, int bid_off) {
    float* tile = (float*)lds;
    if (bid_off > ogrid() / 2) bid_off = 0;
    if (obid() < bid_off) return;
    for (int it = t_lo + (obid() - bid_off); it < t_hi; it += ogrid() - bid_off) {
        if (it < T0) { const int nt = it / 16, kt = it % 16;
            tr_tile(PIN(10) + (size_t)l * 1024 * IN_DIM, IN_DIM, kt * 64, nt * 64, 1, (bf16_t*)(ws + WS_WIN), 1024, 0, tile);
        } else if (it < T1) { const int j = it - T0, nt = j / 8, kt = j % 8;
            tr_tile(PIN(17) + (size_t)l * 512 * 1024, 1024, kt * 64, nt * 64, 0, (bf16_t*)(ws + WS_WBR), 512, 0, tile);
        } else if (it < T2) { const int j = it - T1, nt = j / 4, kt = j % 4;
            tr_tile(PIN(18) + (size_t)l * 256 * 1024, 1024, kt * 64, nt * 64, 0, (bf16_t*)(ws + WS_WBR) + 1024 * 512, 512, 0, tile);
        } else if (it < T2b) { const int j = it - T2, nt = j / 4, kt = j % 4;
            tr_tile(PIN(18), 1024, kt * 64, nt * 64, 3, (bf16_t*)(ws + WS_WBR) + 1024 * 512, 512, 256, tile);
        } else if (it < T2c) { const int j = it - T2b, nt = j / 4, kt = j % 4;
            tr_tile(PIN(19), 1024, kt * 64, nt * 64, 3, (bf16_t*)(ws + WS_WBR) + 2048 * 512, 512, 0, tile);
        } else if (it < T3) { const int j = it - T2c, nt = j / 4, kt = j % 4;
            tr_tile(PIN(19) + (size_t)l * 256 * 1024, 1024, kt * 64, nt * 64, 0, (bf16_t*)(ws + WS_WBR) + 2048 * 512, 512, 256, tile);
        } else if (it < T4) { const int j = it - T3, nt = j / 16, kt = j % 16;
            tr_tile(PIN(20) + (size_t)l * 1024 * 1024, 1024, kt * 64, nt * 64, 0, (bf16_t*)(ws + WS_WO), 1024, 0, tile);
        } else if (it < T5) { const int j = it - T4, nt = j / 16, kt = j % 16;
            tr_tile(PIN(21) + (size_t)l * 1024 * UPN, UPN, kt * 64, nt * 64, 2, (bf16_t*)(ws + WS_WUP), 1024, 0, tile);
        } else { const int j = it - T5, nt = j / 44, kt = j % 44;
            tr_tile(PIN(24) + (size_t)l * DFF * 1024, 1024, kt * 64, nt * 64, 0, (bf16_t*)(ws + WS_WDN), DFF, 0, tile);
        }
    }
}

DI void phase_rowpass(unsigned char* ws, int nrows, const float* xin_lat, const float* xin_ctx, const float* y, const float* gate_base  ,
                      const float* gpost, bool write_x, bool write_h, const float* hmod_base  , int sc_which, int sh_which, const float* gpre) {
    const int lane = otid() & 63, wave = otid() >> 6;
    float eps = EPS; asm volatile("" : "+v"(eps));
    float* xout_lat = (float*)PIN(25); float* xout_ctx = (float*)(ws + WS_CTXRES);
    bf16_t* H = (bf16_t*)(ws + WS_H);
    const int nwv = ogrid() * 8, per = (nrows + nwv - 1) / nwv;
    int r = (obid() * 8 + wave) * per;
    const int rend = min(r + per, nrows);
    f32x4 xv[4], yv[4], xnx[4], ynx[4];
    f32x4 vgt[4], vgp[4], vpre[4], vsc[4], vsh[4];
#pragma unroll
    for (int i = 0; i < 4; ++i) { xv[i] = (f32x4){0.f, 0.f, 0.f, 0.f}; yv[i] = xv[i]; xnx[i] = xv[i]; ynx[i] = xv[i]; vgt[i] = xv[i]; vgp[i] = xv[i]; vpre[i] = xv[i]; vsc[i] = xv[i]; vsh[i] = xv[i]; }
    if (r < rend) {
        const float* xi = r < ML ? xin_lat + (size_t)r * 1024 : xin_ctx + (size_t)(r - ML) * 1024;
#pragma unroll
        for (int i = 0; i < 4; ++i) xv[i] = __builtin_nontemporal_load((const f32x4*)(xi + i * 256 + lane * 4));
        if (y) {
#pragma unroll
            for (int i = 0; i < 4; ++i) yv[i] = __builtin_nontemporal_load((const f32x4*)(y + (size_t)r * 1024 + i * 256 + lane * 4));
        }
#pragma unroll
        for (int i = 0; i < 4; ++i) { if (y) vgp[i] = *(const f32x4*)(gpost + i * 256 + lane * 4); if (write_h) vpre[i] = *(const f32x4*)(gpre + i * 256 + lane * 4); }
    }
    int mi_cur = -1;
#pragma unroll 1
    for (; r < rend; ++r) {
        const int mi = r < ML ? (r >> 12) : 8;
        const int rn = r + 1;
        if (rn < rend) {
            const float* xi = rn < ML ? xin_lat + (size_t)rn * 1024 : xin_ctx + (size_t)(rn - ML) * 1024;
#pragma unroll
            for (int i = 0; i < 4; ++i) xnx[i] = __builtin_nontemporal_load((const f32x4*)(xi + i * 256 + lane * 4));
            if (y) {
#pragma unroll
                for (int i = 0; i < 4; ++i) ynx[i] = __builtin_nontemporal_load((const f32x4*)(y + (size_t)rn * 1024 + i * 256 + lane * 4));
            }
        }
        if (mi != mi_cur) {
            mi_cur = mi;
#pragma unroll
            for (int i = 0; i < 4; ++i) {
                if (y) vgt[i] = *(const f32x4*)(gate_base + (size_t)mi * 6144 + i * 256 + lane * 4);
                if (write_h) { vsc[i] = *(const f32x4*)(hmod_base + ((size_t)mi * 6 + sc_which) * 1024 + i * 256 + lane * 4);
                               vsh[i] = *(const f32x4*)(hmod_base + ((size_t)mi * 6 + sh_which) * 1024 + i * 256 + lane * 4); }
            }
        }
        if (y) {
            float ss = 0.f;
#pragma unroll
            for (int i = 0; i < 4; ++i) ss += yv[i][0] * yv[i][0] + yv[i][1] * yv[i][1] + yv[i][2] * yv[i][2] + yv[i][3] * yv[i][3];
            ss = wave_sum(ss);
            const float rs = rsqrtf(ss * (1.f / 1024.f) + eps);
#pragma unroll
            for (int i = 0; i < 4; ++i)
#pragma unroll
                for (int j = 0; j < 4; ++j) xv[i][j] += vgt[i][j] * (yv[i][j] * rs * vgp[i][j]);
        }
        if (write_x) {
            float* xo = r < ML ? xout_lat + (size_t)r * 1024 : xout_ctx + (size_t)(r - ML) * 1024;
#pragma unroll
            for (int i = 0; i < 4; ++i) __builtin_nontemporal_store(xv[i], (f32x4*)(xo + i * 256 + lane * 4));
        }
        if (write_h) {
            float ss = 0.f;
#pragma unroll
            for (int i = 0; i < 4; ++i) ss += xv[i][0] * xv[i][0] + xv[i][1] * xv[i][1] + xv[i][2] * xv[i][2] + xv[i][3] * xv[i][3];
            ss = wave_sum(ss);
            const float rs = rsqrtf(ss * (1.f / 1024.f) + eps);
#pragma unroll
            for (int i = 0; i < 4; ++i) {
                float hv[4];
#pragma unroll
                for (int j = 0; j < 4; ++j) hv[j] = (xv[i][j] * rs * vpre[i][j]) * (1.f + vsc[i][j]) + vsh[i][j];
                u32x2 o; o[0] = pk_bf16(hv[0], hv[1]); o[1] = pk_bf16(hv[2], hv[3]);
                *(u32x2*)(H + (size_t)r * 1024 + i * 256 + lane * 4) = o;
            }
        }
#pragma unroll
        for (int i = 0; i < 4; ++i) { xv[i] = xnx[i]; yv[i] = ynx[i]; }
    }
}

DI void attn_item(const bf16_t* P, bf16_t* Y, const float* sinkp, const float* rope, unsigned char* lds, bool is_ctx, int b, int blk, int hp) {
    bf16_t* Ks = (bf16_t*)lds;
    const int tid = otid(), wave = tid >> 6, lane = tid & 63, fr = lane & 15, fq = lane >> 4;
    const int kvh = hp >> 1, h = hp * 2 + (wave >> 2);
    const size_t qrow0 = is_ctx ? (size_t)ML + b * 256 + blk * 128 : (size_t)b * 4096 + blk * 128;
    const int qi0 = (wave & 3) * 32 + fr;
    const int sp0 = is_ctx ? 2 : (blk == 0 ? 1 : 0), sp1 = is_ctx ? 4 : (blk == 31 ? 4 : 5);
    u32x4 rk0, rk1, rv0, rv1; f32x4 rrt[4];
    const int skey = tid >> 2, sdq = tid & 3;
#define ATT_LOAD(sp_) do { const int ch_ = (sp_) < 2 ? (sp_) : ((sp_) < 4 ? (sp_) + 1 : 2); size_t kr_; \
        if (ch_ < 3) { const int kb_ = is_ctx ? 0 : blk - 1 + ch_; kr_ = (size_t)b * 4096 + kb_ * 128; \
            const int tk_ = kb_ * 128 + skey; const int pos_ = sdq < 2 ? (tk_ >> 6) : (tk_ & 63); const float* rt_ = rope + (pos_ * 16 + (sdq & 1) * 8) * 2; \
            _Pragma("unroll") for (int j_ = 0; j_ < 4; ++j_) rrt[j_] = *(const f32x4*)(rt_ + 4 * j_); } \
        else kr_ = (size_t)ML + b * 256 + (ch_ - 3) * 128; \
        const bf16_t* kp_ = P + (kr_ + skey) * IN_DIM + C_AK + kvh * 64 + sdq * 8; rk0 = *(const u32x4*)kp_; rk1 = *(const u32x4*)(kp_ + 32); \
        const bf16_t* vp_ = P + (kr_ + skey) * IN_DIM + C_AV + kvh * 64 + sdq * 8; rv0 = *(const u32x4*)vp_; rv1 = *(const u32x4*)(vp_ + 32); } while (0)
    ATT_LOAD(sp0);
    bf16x8 Qf0[2], Qf1[2];
#pragma unroll
    for (int t = 0; t < 2; ++t) {
        const int qi = qi0 + 16 * t, tq = blk * 128 + qi;
        const bf16_t* qp = P + (qrow0 + qi) * IN_DIM + C_AQ + h * 64 + fq * 8;
        const u32x4 q0 = *(const u32x4*)qp, q1 = *(const u32x4*)(qp + 32);
        float qa[8], qb[8];
#pragma unroll
        for (int j = 0; j < 4; ++j) { qa[2 * j] = lo_f(q0[j]); qa[2 * j + 1] = hi_f(q0[j]); qb[2 * j] = lo_f(q1[j]); qb[2 * j + 1] = hi_f(q1[j]); }
        if (!is_ctx) {
            const int pos = fq < 2 ? (tq >> 6) : (tq & 63);
            const float* rt = rope + (pos * 16 + (fq & 1) * 8) * 2;
#pragma unroll
            for (int j = 0; j < 8; ++j) { const float c = rt[2 * j], s = rt[2 * j + 1]; const float a = qa[j], bb = qb[j]; qa[j] = a * c - bb * s; qb[j] = a * s + bb * c; }
        }
        const float qs = 0.125f * 1.4426950408889634f;
        u32x4 o0, o1;
#pragma unroll
        for (int j = 0; j < 4; ++j) { o0[j] = pk_bf16_mfma(qa[2 * j] * qs, qa[2 * j + 1] * qs); o1[j] = pk_bf16_mfma(qb[2 * j] * qs, qb[2 * j + 1] * qs); }
        Qf0[t] = __builtin_bit_cast(bf16x8, o0); Qf1[t] = __builtin_bit_cast(bf16x8, o1);
    }
    float m_run[2], l_run[2];
    f32x4 O[2][4];
    {   const float sk = sinkp[h] * 1.4426950408889634f;
#pragma unroll
        for (int t = 0; t < 2; ++t) { m_run[t] = sk; l_run[t] = 1.f;
#pragma unroll
            for (int dt = 0; dt < 4; ++dt) O[t][dt] = (f32x4){0.f, 0.f, 0.f, 0.f}; } }
    __syncthreads();
#pragma unroll 1
    for (int sp = sp0; sp < sp1; ++sp) {
        const int ch = sp < 2 ? sp : (sp < 4 ? sp + 1 : 2);
        const int mask = (ch < 3 && !is_ctx) ? ch : 1;
        const int bufsel = (sp - sp0) & 1;
        bf16_t* Kb = Ks + bufsel * (2 * 128 * 72);
        bf16_t* Vb = Kb + 128 * 72;
        {
            u32x4 k0 = rk0, k1 = rk1;
            if (ch < 3) {
                float ka[8], kb2[8];
#pragma unroll
                for (int j = 0; j < 4; ++j) { ka[2 * j] = lo_f(k0[j]); ka[2 * j + 1] = hi_f(k0[j]); kb2[2 * j] = lo_f(k1[j]); kb2[2 * j + 1] = hi_f(k1[j]); }
#pragma unroll
                for (int j = 0; j < 8; ++j) { const float c = rrt[j >> 1][(j & 1) * 2], s = rrt[j >> 1][(j & 1) * 2 + 1]; const float a = ka[j], bb = kb2[j]; ka[j] = a * c - bb * s; kb2[j] = a * s + bb * c; }
#pragma unroll
                for (int j = 0; j < 4; ++j) { k0[j] = pk_bf16(ka[2 * j], ka[2 * j + 1]); k1[j] = pk_bf16(kb2[2 * j], kb2[2 * j + 1]); }
            }
            *(u32x4*)(Kb + skey * 72 + sdq * 8) = k0;
            *(u32x4*)(Kb + skey * 72 + 32 + sdq * 8) = k1;
            *(u32x4*)(Vb + skey * 72 + sdq * 8) = rv0;
            *(u32x4*)(Vb + skey * 72 + 32 + sdq * 8) = rv1;
        }
        if (sp + 1 < sp1) ATT_LOAD(sp + 1);
        __syncthreads();
        f32x4 S[2][8];
#pragma unroll
        for (int kt = 0; kt < 8; ++kt) {
            const bf16x8 a0 = *(const bf16x8*)(Kb + (kt * 16 + fr) * 72 + fq * 8);
            const bf16x8 a1 = *(const bf16x8*)(Kb + (kt * 16 + fr) * 72 + 32 + fq * 8);
#pragma unroll
            for (int t = 0; t < 2; ++t) {
                f32x4 z = (f32x4){0.f, 0.f, 0.f, 0.f};
                z = __builtin_amdgcn_mfma_f32_16x16x32_bf16(a0, Qf0[t], z, 0, 0, 0);
                S[t][kt] = __builtin_amdgcn_mfma_f32_16x16x32_bf16(a1, Qf1[t], z, 0, 0, 0);
            }
        }
#pragma unroll
        for (int t = 0; t < 2; ++t) {
            if (mask != 1) {
                int dq = qi0 + 16 * t - fq * 4; float negbig = -1e30f; asm volatile("" : "+v"(dq), "+v"(negbig));
                if (mask == 2) dq = -dq;
#pragma unroll
                for (int kt = 0; kt < 8; ++kt)
#pragma unroll
                    for (int j = 0; j < 4; ++j) { const int kk = kt * 16 + j; const bool ok = (mask == 0) ? (kk >= dq) : (-kk >= dq); if (!ok) S[t][kt][j] = negbig; }
            }
            float mx = -1e30f;
#pragma unroll
            for (int kt = 0; kt < 8; ++kt)
#pragma unroll
                for (int j = 0; j < 4; ++j) mx = fmaxf(mx, S[t][kt][j]);
            mx = fmaxf(mx, shx(mx, 16, lane)); mx = fmaxf(mx, shx(mx, 32, lane));
            const float m_new = fmaxf(m_run[t], mx);
            const float alpha = __builtin_amdgcn_exp2f(m_run[t] - m_new);
            float sum = 0.f;
#pragma unroll
            for (int kt = 0; kt < 8; ++kt)
#pragma unroll
                for (int j = 0; j < 4; ++j) { const float e = __builtin_amdgcn_exp2f(S[t][kt][j] - m_new); S[t][kt][j] = e; sum += e; }
            sum += shx(sum, 16, lane); sum += shx(sum, 32, lane);
            l_run[t] = l_run[t] * alpha + sum; m_run[t] = m_new;
#pragma unroll
            for (int dt = 0; dt < 4; ++dt)
#pragma unroll
                for (int j = 0; j < 4; ++j) O[t][dt][j] *= alpha;
        }
#pragma unroll
        for (int i = 0; i < 4; ++i) {
            bf16x8 Pf[2];
#pragma unroll
            for (int t = 0; t < 2; ++t) {
                u32x4 pw; pw[0] = pk_bf16_mfma(S[t][2 * i][0], S[t][2 * i][1]); pw[1] = pk_bf16_mfma(S[t][2 * i][2], S[t][2 * i][3]); pw[2] = pk_bf16_mfma(S[t][2 * i + 1][0], S[t][2 * i + 1][1]); pw[3] = pk_bf16_mfma(S[t][2 * i + 1][2], S[t][2 * i + 1][3]);
                Pf[t] = __builtin_bit_cast(bf16x8, pw);
            }
#pragma unroll
            for (int dt = 0; dt < 4; ++dt) {
                const s16x4 lo = __builtin_amdgcn_ds_read_tr16_b64_v4i16((LAS s16x4*)(Vb + (32 * i + fq * 4 + (fr >> 2)) * 72 + dt * 16 + 4 * (fr & 3)));
                const s16x4 hi = __builtin_amdgcn_ds_read_tr16_b64_v4i16((LAS s16x4*)(Vb + (32 * i + 16 + fq * 4 + (fr >> 2)) * 72 + dt * 16 + 4 * (fr & 3)));
                const bf16x8 Vf = __builtin_shufflevector(lo, hi, 0, 1, 2, 3, 4, 5, 6, 7);
#pragma unroll
                for (int t = 0; t < 2; ++t) O[t][dt] = __builtin_amdgcn_mfma_f32_16x16x32_bf16(Vf, Pf[t], O[t][dt], 0, 0, 0);
            }
        }
    }
#undef ATT_LOAD
#pragma unroll
    for (int t = 0; t < 2; ++t) {
        const float inv = 1.f / l_run[t];
        bf16_t* yp = Y + (qrow0 + qi0 + 16 * t) * 1024 + h * 64 + fq * 4;
#pragma unroll
        for (int dt = 0; dt < 4; ++dt) { u32x2 o; o[0] = pk_bf16(O[t][dt][0] * inv, O[t][dt][1] * inv); o[1] = pk_bf16(O[t][dt][2] * inv, O[t][dt][3] * inv); *(u32x2*)(yp + dt * 16) = o; }
    }
    __syncthreads();
}

template <int W> DI void pool_window(const bf16_t* us, bf16_t* dd, int tid, int chn, int t0, int T) {
    constexpr int lo = W / 2, hi = W - lo - 1;
#pragma unroll 2
    for (int i = 0; i < 32; ++i) {
        const int tt = (tid >> 8) + 2 * i, t = t0 + tt;
        float s = 0.f;
#pragma unroll
        for (int k = -lo; k <= hi; ++k) s += bf2f(us[(tt + 8 + k) * 256 + chn]);
        const int cnt = min(t + hi + 1, T) - max(t - lo, 0);
        dd[tt * 264 + chn] = f2bf(s / (float)cnt - bf2f(us[(tt + 8) * 256 + chn]));
    }
}

DI void pool_item(const bf16_t* P, bf16_t* Y, const float* pool_w, const float* pool_scale, unsigned char* lds, int cid) {
    bf16_t* us = (bf16_t*)lds;
    bf16_t* dd = (bf16_t*)(lds + 79 * 256 * 2 + 64);
    bf16_t* Wt = dd + 64 * 264;
    const int tid = otid();
    const int row0 = cid * 64;
    int seq0, T;
    if (cid < 512) { seq0 = (cid >> 6) * 4096; T = 4096; } else { seq0 = ML + ((cid - 512) >> 2) * 256; T = 256; }
    const int t0 = row0 - seq0;
    __syncthreads();
#pragma unroll
    for (int i = 0; i < 5; ++i) {
        const int c = tid + i * NTHR;
        if (c < 79 * 32) {
            const int rr = c >> 5, cc = (c & 31) * 8; const int t = t0 - 8 + rr;
            u32x4 v = (u32x4){0u, 0u, 0u, 0u};
            if (t >= 0 && t < T) v = *(const u32x4*)(P + (size_t)(seq0 + t) * IN_DIM + C_PU + cc);
            *(u32x4*)(us + rr * 256 + cc) = v;
        }
    }
#pragma unroll
    for (int i = 0; i < 8; ++i) {
        const int c = tid + i * NTHR; const int gi = c >> 4, o4 = (c & 15) * 4;
        const f32x4 wv = *(const f32x4*)(pool_w + (size_t)gi * 64 + o4);
        u32x2 wo; wo[0] = pk_bf16(wv[0], wv[1]); wo[1] = pk_bf16(wv[2], wv[3]);
        *(u32x2*)(Wt + gi * 72 + o4) = wo;
    }
    __syncthreads();
    {
        const int chn = tid & 255, g = chn >> 6;
        if (g == 0) pool_window<2>(us, dd, tid, chn, t0, T);
        else if (g == 1) pool_window<4>(us, dd, tid, chn, t0, T);
        else if (g == 2) pool_window<8>(us, dd, tid, chn, t0, T);
        else pool_window<16>(us, dd, tid, chn, t0, T);
    }
    __syncthreads();
    {
        const int lane = tid & 63, fr = lane & 15, fq = lane >> 4, w = tid >> 6, g = w >> 1, th = w & 1;
#pragma unroll
        for (int mt = 0; mt < 2; ++mt)
#pragma unroll
            for (int nt = 0; nt < 4; ++nt) {
                f32x4 acc = (f32x4){0.f, 0.f, 0.f, 0.f};
#pragma unroll
                for (int ks = 0; ks < 2; ++ks) {
                    const bf16x8 a = *(const bf16x8*)(dd + (th * 32 + mt * 16 + fr) * 264 + g * 64 + ks * 32 + fq * 8);
                    const int wr_ = g * 64 + ks * 32 + fq * 8 + (fr >> 2), wc_ = nt * 16 + 4 * (fr & 3);
                    const s16x4 b0 = __builtin_amdgcn_ds_read_tr16_b64_v4i16((LAS s16x4*)(Wt + wr_ * 72 + wc_)), b1 = __builtin_amdgcn_ds_read_tr16_b64_v4i16((LAS s16x4*)(Wt + (wr_ + 4) * 72 + wc_));
                    const bf16x8 b = __builtin_shufflevector(b0, b1, 0, 1, 2, 3, 4, 5, 6, 7);
                    acc = __builtin_amdgcn_mfma_f32_16x16x32_bf16(b, a, acc, 0, 0, 0);
                }
                const f32x4 ps = *(const f32x4*)(pool_scale + g * 64 + nt * 16 + fq * 4);
                u32x2 o; o[0] = pk_bf16(acc[0] * ps[0], acc[1] * ps[1]); o[1] = pk_bf16(acc[2] * ps[2], acc[3] * ps[3]);
                *(u32x2*)(Y + (size_t)(row0 + th * 32 + mt * 16 + fr) * 1024 + 512 + g * 64 + nt * 16 + fq * 4) = o;
            }
    }
}

constexpr int GL_Q = 0, GL_K = GL_Q + 64 * 33, GL_V = GL_K + 64 * 33, GL_G = GL_V + 64 * 68, GL_BF = GL_G + 64 * 33, GL_BB = GL_BF + 64 * 33,
              GL_QT = GL_BB + 64 * 33, GL_KT = GL_QT + 64 * 33, GL_ATT = GL_KT + 64 * 33, GL_S = GL_ATT + 64 * 68, GL_END = GL_S + 32 * 68;
static_assert(GL_END * 4 <= 131072, "gla lds");
constexpr int G3_B0 = GL_QT * 4;
constexpr int G3_QT = G3_B0, G3_KT = G3_QT + 2 * 64 * 40 * 2, G3_ATT = G3_KT + 2 * 64 * 40 * 2, G3_VT = G3_ATT + 2 * 64 * 72 * 2,
              G3_ST = G3_VT + 64 * 72 * 2, G3_END = G3_ST + 2 * 32 * 72 * 2;
static_assert(G3_END <= 131072, "gla3 lds");

DI void gla_load(const bf16_t* P, const float* wa2  , const float* ba  , float* L, int cid, int hh) {
    const int tid = otid();
    const size_t row0 = (size_t)cid * 64;
    __syncthreads();
    {
        const int r = tid >> 3, d0 = (tid & 7) * 4;
        const bf16_t* rp = P + (row0 + r) * IN_DIM;
        const u32x2 kv = *(const u32x2*)(rp + C_GK + hh * 32 + d0), gv = *(const u32x2*)(rp + C_GLR + d0);
        L[GL_K + r * 33 + d0] = lo_f(kv[0]); L[GL_K + r * 33 + d0 + 1] = hi_f(kv[0]); L[GL_K + r * 33 + d0 + 2] = lo_f(kv[1]); L[GL_K + r * 33 + d0 + 3] = hi_f(kv[1]);
        L[GL_G + r * 33 + d0] = lo_f(gv[0]); L[GL_G + r * 33 + d0 + 1] = hi_f(gv[0]); L[GL_G + r * 33 + d0 + 2] = lo_f(gv[1]); L[GL_G + r * 33 + d0 + 3] = hi_f(gv[1]);
        const int e0 = (tid & 7) * 8;
        const u32x4 vv = *(const u32x4*)(rp + C_GV + hh * 64 + e0);
        {
            const int idx = tid * 2, wd = idx >> 9, wr_ = (idx >> 5) & 15, wdd = idx & 31;
            const f32x2 wv2 = *(const f32x2*)(wa2 + (wd * 16 + wr_) * 128 + hh * 32 + wdd);
            *(f32x2*)(L + GL_S + idx) = wv2;
            if (tid < 64) L[GL_S + 1024 + tid] = ba[(tid >> 5) * 128 + hh * 32 + (tid & 31)];
        }
        *(u32x4*)((bf16_t*)((unsigned char*)L + G3_VT) + r * 72 + e0) = vv;
    }
    __syncthreads();
    {
        const int r = tid >> 3, d0 = (tid & 7) * 4;
#pragma unroll
        for (int dir = 0; dir < 2; ++dir) {
            f32x4 z = *(const f32x4*)(L + GL_S + 1024 + dir * 32 + d0);
#pragma unroll
            for (int rr = 0; rr < 16; ++rr) {
                const float gl = L[GL_G + r * 33 + dir * 16 + rr];
                const f32x4 w = *(const f32x4*)(L + GL_S + (dir * 16 + rr) * 32 + d0);
                z[0] += gl * w[0]; z[1] += gl * w[1]; z[2] += gl * w[2]; z[3] += gl * w[3];
            }
#pragma unroll
            for (int j = 0; j < 4; ++j) {
                const float zz = z[j];
                const float ls = fminf(zz, 0.f) - __logf(1.f + __expf(-fabsf(zz)));
                L[(dir ? GL_BB : GL_BF) + r * 33 + d0 + j] = ls * (1.f / 16.f);
            }
        }
    }
    __syncthreads();
    {
        const int lane = tid & 63, wv = tid >> 6;
#pragma unroll
        for (int c = 0; c < 4; ++c) {
            const int d = wv * 4 + c;
            float vf = L[GL_BF + lane * 33 + d], vb = L[GL_BB + lane * 33 + d];
#pragma unroll
            for (int off = 1; off < 64; off <<= 1) {
                const float tf = __int_as_float(__builtin_amdgcn_ds_bpermute(((lane - off) & 63) << 2, __float_as_int(vf)));
                const float tb = __int_as_float(__builtin_amdgcn_ds_bpermute(((lane + off) & 63) << 2, __float_as_int(vb)));
                vf += (lane >= off) ? tf : 0.f;
                vb += (lane + off < 64) ? tb : 0.f;
            }
            L[GL_BF + lane * 33 + d] = vf; L[GL_BB + lane * 33 + d] = vb;
        }
    }
    __syncthreads();
}

DI void gla_load3(const bf16_t* P, const float* GBi, float* L, int cid, int hh) {
    const int tid = otid();
    const size_t row0 = (size_t)cid * 64;
    __syncthreads();
    {
        const int r = tid >> 3, d0 = (tid & 7) * 4;
        const bf16_t* rp = P + (row0 + r) * IN_DIM;
        const u32x2 qv = *(const u32x2*)(rp + C_GQ + hh * 32 + d0), kv = *(const u32x2*)(rp + C_GK + hh * 32 + d0);
        const f32x4 bfv = *(const f32x4*)(GBi + r * 32 + d0), bbv = *(const f32x4*)(GBi + 2048 + r * 32 + d0);
        const int e0 = (tid & 7) * 8;
        const u32x4 vv = *(const u32x4*)(rp + C_GV + hh * 64 + e0);
        const float qs = 0.17677669529663687f;
        L[GL_Q + r * 33 + d0] = lo_f(qv[0]) * qs; L[GL_Q + r * 33 + d0 + 1] = hi_f(qv[0]) * qs; L[GL_Q + r * 33 + d0 + 2] = lo_f(qv[1]) * qs; L[GL_Q + r * 33 + d0 + 3] = hi_f(qv[1]) * qs;
        L[GL_K + r * 33 + d0] = lo_f(kv[0]); L[GL_K + r * 33 + d0 + 1] = hi_f(kv[0]); L[GL_K + r * 33 + d0 + 2] = lo_f(kv[1]); L[GL_K + r * 33 + d0 + 3] = hi_f(kv[1]);
#pragma unroll
        for (int j = 0; j < 4; ++j) { L[GL_BF + r * 33 + d0 + j] = bfv[j]; L[GL_BB + r * 33 + d0 + j] = bbv[j]; }
        *(f32x4*)(L + GL_V + r * 68 + e0) = (f32x4){lo_f(vv[0]), hi_f(vv[0]), lo_f(vv[1]), hi_f(vv[1])};
        *(f32x4*)(L + GL_V + r * 68 + e0 + 4) = (f32x4){lo_f(vv[2]), hi_f(vv[2]), lo_f(vv[3]), hi_f(vv[3])};
    }
    __syncthreads();
}

DI void gla_pass1_item(unsigned char* ws, const float* wa2, const float* gba, unsigned char* lds, int cid, int hh) {
    float* L = (float*)lds;
    const bf16_t* P = (const bf16_t*)(ws + WS_P);
    gla_load(P, wa2, gba, L, cid, hh);
    const int tid = otid();
    float* GKV = (float*)(ws + WS_M2); float* GDEC = (float*)(ws + WS_GDEC);
    {
        float* GB = (float*)(ws + WS_M2) + (size_t)NCH * 4 * 2 * 2048 + ((size_t)cid * 4 + hh) * 4096;
        const int r = tid >> 3, d0 = (tid & 7) * 4;
        *(f32x4*)(GB + r * 32 + d0) = (f32x4){L[GL_BF + r * 33 + d0], L[GL_BF + r * 33 + d0 + 1], L[GL_BF + r * 33 + d0 + 2], L[GL_BF + r * 33 + d0 + 3]};
        *(f32x4*)(GB + 2048 + r * 32 + d0) = (f32x4){L[GL_BB + r * 33 + d0], L[GL_BB + r * 33 + d0 + 1], L[GL_BB + r * 33 + d0 + 2], L[GL_BB + r * 33 + d0 + 3]};
    }
    bf16_t* KD = (bf16_t*)(lds + G3_QT);
    bf16_t* VB = (bf16_t*)(lds + G3_VT);
    {
        const int c = tid >> 3, d0 = (tid & 7) * 4;
        float kf[4], kb[4];
#pragma unroll
        for (int j = 0; j < 4; ++j) {
            const float k = L[GL_K + c * 33 + d0 + j];
            kf[j] = k * __expf(L[GL_BF + 63 * 33 + d0 + j] - L[GL_BF + c * 33 + d0 + j]);
            kb[j] = k * __expf(L[GL_BB + 0 * 33 + d0 + j] - L[GL_BB + c * 33 + d0 + j]);
        }
        u32x2 o;
        o[0] = pk_bf16(kf[0], kf[1]); o[1] = pk_bf16(kf[2], kf[3]); *(u32x2*)(KD + c * 40 + d0) = o;
        o[0] = pk_bf16(kb[0], kb[1]); o[1] = pk_bf16(kb[2], kb[3]); *(u32x2*)(KD + 64 * 40 + c * 40 + d0) = o;
    }
    __syncthreads();
    const size_t idx = ((size_t)cid * 4 + hh) * 2;
    {
        const int lane = tid & 63, fr = lane & 15, fq = lane >> 4, wv = tid >> 6, dir = wv >> 2, et = wv & 3;
        const bf16_t* KDd = KD + dir * 64 * 40;
        f32x4 a0 = (f32x4){0.f, 0.f, 0.f, 0.f}, a1 = a0;
#pragma unroll
        for (int ks = 0; ks < 2; ++ks) {
            const int trr = ks * 32 + fq * 8 + (fr >> 2), trc = 4 * (fr & 3);
            const s16x4 v0 = __builtin_amdgcn_ds_read_tr16_b64_v4i16((LAS s16x4*)(VB + trr * 72 + et * 16 + trc)), v1 = __builtin_amdgcn_ds_read_tr16_b64_v4i16((LAS s16x4*)(VB + (trr + 4) * 72 + et * 16 + trc));
            const s16x4 k00 = __builtin_amdgcn_ds_read_tr16_b64_v4i16((LAS s16x4*)(KDd + trr * 40 + trc)), k01 = __builtin_amdgcn_ds_read_tr16_b64_v4i16((LAS s16x4*)(KDd + (trr + 4) * 40 + trc));
            const s16x4 k10 = __builtin_amdgcn_ds_read_tr16_b64_v4i16((LAS s16x4*)(KDd + trr * 40 + 16 + trc)), k11 = __builtin_amdgcn_ds_read_tr16_b64_v4i16((LAS s16x4*)(KDd + (trr + 4) * 40 + 16 + trc));
            const bf16x8 vf = __builtin_shufflevector(v0, v1, 0, 1, 2, 3, 4, 5, 6, 7);
            const bf16x8 kf0 = __builtin_shufflevector(k00, k01, 0, 1, 2, 3, 4, 5, 6, 7), kf1 = __builtin_shufflevector(k10, k11, 0, 1, 2, 3, 4, 5, 6, 7);
            a0 = __builtin_amdgcn_mfma_f32_16x16x32_bf16(vf, kf0, a0, 0, 0, 0);
            a1 = __builtin_amdgcn_mfma_f32_16x16x32_bf16(vf, kf1, a1, 0, 0, 0);
        }
        float* gk = GKV + (idx + dir) * 2048 + et * 16 + fq * 4;
        *(f32x4*)(gk + (size_t)fr * 64) = a0;
        *(f32x4*)(gk + (size_t)(16 + fr) * 64) = a1;
    }
    if (tid < 32) GDEC[idx * 32 + tid] = __expf(L[GL_BF + 63 * 33 + tid]);
    else if (tid < 64) GDEC[(idx + 1) * 32 + (tid - 32)] = __expf(L[GL_BB + 0 * 33 + (tid - 32)]);
}

DI void phase_gla_scan(unsigned char* ws) {
    float* GKV = (float*)(ws + WS_M2); const float* GDEC = (const float*)(ws + WS_GDEC);
    const int tid = otid();
    for (int vb = obid(); vb < 256; vb += ogrid()) {
        const int sid = vb >> 2, quarter = vb & 3; const int b = sid >> 3, hh = (sid >> 1) & 3, dir = sid & 1;
        const int elem = quarter * 512 + tid, d = elem >> 6;
        float S = 0.f;
        for (int s0 = 0; s0 < 68; s0 += 17) {
            float kv[17], dc[17]; unsigned ix[17];
#pragma unroll
            for (int u = 0; u < 17; ++u) {
                const int s = s0 + u;
                int cid;
                if (dir == 0) cid = s < 4 ? 512 + b * 4 + s : b * 64 + (s - 4);
                else cid = s < 4 ? 512 + b * 4 + (3 - s) : b * 64 + (63 - (s - 4));
                ix[u] = (unsigned)((cid * 4 + hh) * 2 + dir);
                kv[u] = GKV[(size_t)ix[u] * 2048 + elem]; dc[u] = GDEC[ix[u] * 32 + d];
            }
#pragma unroll
            for (int u = 0; u < 17; ++u) { GKV[(size_t)ix[u] * 2048 + elem] = S; S = S * dc[u] + kv[u]; }
        }
    }
}

DI void gla_pass3_item(unsigned char* ws, const float* wa2, const float* gba, const float* gnorm, unsigned char* lds, int cid, int hh) {
    float* L = (float*)lds;
    const bf16_t* P = (const bf16_t*)(ws + WS_P);
    bf16_t* Y = (bf16_t*)(ws + WS_H);
    const int tid = otid(), lane = tid & 63, fr = lane & 15, fq = lane >> 4, wv = tid >> 6, dir = wv >> 2, mt = wv & 3;
    bf16_t* QT = (bf16_t*)(lds + G3_QT); bf16_t* KT = (bf16_t*)(lds + G3_KT); bf16_t* ATT = (bf16_t*)(lds + G3_ATT);
    bf16_t* VT = (bf16_t*)(lds + G3_VT); bf16_t* ST = (bf16_t*)(lds + G3_ST);
    float* OB = L + GL_Q;
    {
        const int c = tid >> 3, d0 = (tid & 7) * 4, e0 = (tid & 7) * 8;
        const bf16_t* rp = P + ((size_t)cid * 64 + c) * IN_DIM;
        const float* GBi = (const float*)(ws + WS_M2) + (size_t)NCH * 4 * 2 * 2048 + ((size_t)cid * 4 + hh) * 4096;
        const u32x2 qv = *(const u32x2*)(rp + C_GQ + hh * 32 + d0), kv = *(const u32x2*)(rp + C_GK + hh * 32 + d0);
        const f32x4 bfv = *(const f32x4*)(GBi + c * 32 + d0), bbv = *(const f32x4*)(GBi + 2048 + c * 32 + d0);
        const u32x4 vv = *(const u32x4*)(rp + C_GV + hh * 64 + e0);
        const int sd = tid >> 8, d = (tid & 255) >> 3;
        const float* GSp = (const float*)(ws + WS_M2) + (((size_t)cid * 4 + hh) * 2 + sd) * 2048 + d * 64 + e0;
        const f32x4 s0 = *(const f32x4*)GSp, s1 = *(const f32x4*)(GSp + 4);
        __syncthreads();
        const float qs = 0.17677669529663687f;
        const float qq[4] = {lo_f(qv[0]) * qs, hi_f(qv[0]) * qs, lo_f(qv[1]) * qs, hi_f(qv[1]) * qs};
        const float kk[4] = {lo_f(kv[0]), hi_f(kv[0]), lo_f(kv[1]), hi_f(kv[1])};
        float qf[4], kf[4], qb[4], kb[4];
#pragma unroll
        for (int j = 0; j < 4; ++j) { qf[j] = qq[j] * __expf(bfv[j]); kf[j] = kk[j] * __expf(-bfv[j]); qb[j] = qq[j] * __expf(bbv[j]); kb[j] = kk[j] * __expf(-bbv[j]); }
        u32x2 o;
        o[0] = pk_bf16(qf[0], qf[1]); o[1] = pk_bf16(qf[2], qf[3]); *(u32x2*)(QT + c * 40 + d0) = o;
        o[0] = pk_bf16(kf[0], kf[1]); o[1] = pk_bf16(kf[2], kf[3]); *(u32x2*)(KT + c * 40 + d0) = o;
        o[0] = pk_bf16(qb[0], qb[1]); o[1] = pk_bf16(qb[2], qb[3]); *(u32x2*)(QT + 64 * 40 + c * 40 + d0) = o;
        o[0] = pk_bf16(kb[0], kb[1]); o[1] = pk_bf16(kb[2], kb[3]); *(u32x2*)(KT + 64 * 40 + c * 40 + d0) = o;
        *(u32x4*)(VT + c * 72 + e0) = vv;
        {   u32x4 so; so[0] = pk_bf16(s0[0], s0[1]); so[1] = pk_bf16(s0[2], s0[3]); so[2] = pk_bf16(s1[0], s1[1]); so[3] = pk_bf16(s1[2], s1[3]);
            *(u32x4*)(ST + sd * 32 * 72 + d * 72 + e0) = so; }
    }
    __syncthreads();
    const bf16_t* QTd = QT + dir * 64 * 40; const bf16_t* KTd = KT + dir * 64 * 40; bf16_t* ATTd = ATT + dir * 64 * 72; const bf16_t* STd = ST + dir * 32 * 72;
    {
        const bf16x8 qfrag = *(const bf16x8*)(QTd + (mt * 16 + fr) * 40 + fq * 8);
        const int i = mt * 16 + fr;
#pragma unroll
        for (int nt = 0; nt < 4; ++nt) {
            const bf16x8 kfrag = *(const bf16x8*)(KTd + (nt * 16 + fr) * 40 + fq * 8);
            f32x4 a = (f32x4){0.f, 0.f, 0.f, 0.f};
            a = __builtin_amdgcn_mfma_f32_16x16x32_bf16(kfrag, qfrag, a, 0, 0, 0);
            float r[4];
#pragma unroll
            for (int jq = 0; jq < 4; ++jq) { const int j = nt * 16 + fq * 4 + jq; const int dji = dir ? (j - i) : (i - j); r[jq] = (dji >= 0) ? a[jq] : 0.f; }
            u32x2 o; o[0] = pk_bf16(r[0], r[1]); o[1] = pk_bf16(r[2], r[3]);
            *(u32x2*)(ATTd + (mt * 16 + fr) * 72 + nt * 16 + fq * 4) = o;
        }
    }
    __syncthreads();
    f32x4 o4[4];
    {
        const bf16x8 af0 = *(const bf16x8*)(ATTd + (mt * 16 + fr) * 72 + fq * 8), af1 = *(const bf16x8*)(ATTd + (mt * 16 + fr) * 72 + 32 + fq * 8);
        const bf16x8 qfrag = *(const bf16x8*)(QTd + (mt * 16 + fr) * 40 + fq * 8);
#pragma unroll
        for (int nt = 0; nt < 4; ++nt) {
            const int trc = nt * 16 + 4 * (fr & 3), trr = fq * 8 + (fr >> 2);
            const s16x4 v0a = __builtin_amdgcn_ds_read_tr16_b64_v4i16((LAS s16x4*)(VT + (trr) * 72 + trc)), v0b = __builtin_amdgcn_ds_read_tr16_b64_v4i16((LAS s16x4*)(VT + (trr + 4) * 72 + trc));
            const s16x4 v1a = __builtin_amdgcn_ds_read_tr16_b64_v4i16((LAS s16x4*)(VT + (32 + trr) * 72 + trc)), v1b = __builtin_amdgcn_ds_read_tr16_b64_v4i16((LAS s16x4*)(VT + (32 + trr + 4) * 72 + trc));
            const s16x4 sfa = __builtin_amdgcn_ds_read_tr16_b64_v4i16((LAS s16x4*)(STd + (trr) * 72 + trc)), sfb = __builtin_amdgcn_ds_read_tr16_b64_v4i16((LAS s16x4*)(STd + (trr + 4) * 72 + trc));
            const bf16x8 v0 = __builtin_shufflevector(v0a, v0b, 0, 1, 2, 3, 4, 5, 6, 7), v1 = __builtin_shufflevector(v1a, v1b, 0, 1, 2, 3, 4, 5, 6, 7), sf = __builtin_shufflevector(sfa, sfb, 0, 1, 2, 3, 4, 5, 6, 7);
            f32x4 a = (f32x4){0.f, 0.f, 0.f, 0.f};
            a = __builtin_amdgcn_mfma_f32_16x16x32_bf16(v0, af0, a, 0, 0, 0);
            a = __builtin_amdgcn_mfma_f32_16x16x32_bf16(v1, af1, a, 0, 0, 0);
            a = __builtin_amdgcn_mfma_f32_16x16x32_bf16(sf, qfrag, a, 0, 0, 0);
            o4[nt] = a;
        }
    }
    if (dir == 1) {
#pragma unroll
        for (int nt = 0; nt < 4; ++nt) {
            float* ob = OB + (mt * 16 + fr) * 66 + nt * 16 + fq * 4;
            *(f32x2*)ob = (f32x2){o4[nt][0], o4[nt][1]}; *(f32x2*)(ob + 2) = (f32x2){o4[nt][2], o4[nt][3]};
        }
    }
    __syncthreads();
    if (dir == 0) {
        float ss = 0.f;
#pragma unroll
        for (int nt = 0; nt < 4; ++nt) {
            const float* ob = OB + (mt * 16 + fr) * 66 + nt * 16 + fq * 4;
            const f32x2 b0 = *(const f32x2*)ob, b1 = *(const f32x2*)(ob + 2);
            o4[nt][0] += b0[0]; o4[nt][1] += b0[1]; o4[nt][2] += b1[0]; o4[nt][3] += b1[1];
            ss += o4[nt][0] * o4[nt][0] + o4[nt][1] * o4[nt][1] + o4[nt][2] * o4[nt][2] + o4[nt][3] * o4[nt][3];
        }
        ss += shx(ss, 16, lane); ss += shx(ss, 32, lane);
        float eps = EPS; asm volatile("" : "+v"(eps));
        const float rs = rsqrtf(ss * (1.f / 64.f) + eps);
        const size_t row = (size_t)cid * 64 + mt * 16 + fr;
#pragma unroll
        for (int nt = 0; nt < 4; ++nt) {
            const int e = nt * 16 + fq * 4;
            const f32x4 gn = *(const f32x4*)(gnorm + hh * 64 + e);
            const u32x2 rv = *(const u32x2*)(P + row * IN_DIM + C_GR + hh * 64 + e);
            const float r0 = lo_f(rv[0]), r1 = hi_f(rv[0]), r2 = lo_f(rv[1]), r3 = hi_f(rv[1]);
            u32x2 ov; ov[0] = pk_bf16(o4[nt][0] * rs * gn[0] * siluf_(r0), o4[nt][1] * rs * gn[1] * siluf_(r1)); ov[1] = pk_bf16(o4[nt][2] * rs * gn[2] * siluf_(r2), o4[nt][3] * rs * gn[3] * siluf_(r3));
            *(u32x2*)(Y + row * 1024 + 768 + hh * 64 + e) = ov;
        }
    }
}

DI void phase_conv_fixup(const float* EDGE, bf16_t* ACT, const float* cw, const float* cb) {
    const int ntask = 128 * 2 * 704;
    for (int task = obid() * NTHR + otid(); task < ntask; task += ogrid() * NTHR) {
        const int jg = task % 704, tw = task / 704, which = tw & 1, pm = tw >> 1;
        const int j0 = jg * 4, ucol = (j0 >> 7) * 256 + (j0 & 127);
        const float *pr, *cu, *nx; int row;
        if (which == 0) { if ((pm & 15) == 0) continue; pr = EDGE + ((size_t)(pm - 1) * 4 + 3) * UPN; cu = EDGE + ((size_t)pm * 4 + 0) * UPN; nx = EDGE + ((size_t)pm * 4 + 1) * UPN; row = pm * 256; }
        else { if ((pm & 15) == 15) continue; pr = EDGE + ((size_t)pm * 4 + 2) * UPN; cu = EDGE + ((size_t)pm * 4 + 3) * UPN; nx = EDGE + ((size_t)(pm + 1) * 4 + 0) * UPN; row = pm * 256 + 255; }
        const f32x4 pa = *(const f32x4*)(pr + ucol), pg = *(const f32x4*)(pr + ucol + 128), ca = *(const f32x4*)(cu + ucol), cg_ = *(const f32x4*)(cu + ucol + 128), na = *(const f32x4*)(nx + ucol), ng = *(const f32x4*)(nx + ucol + 128);
        const f32x4 w0a = *(const f32x4*)(cw + j0), w1a = *(const f32x4*)(cw + UPN + j0), w2a = *(const f32x4*)(cw + 2 * UPN + j0), bba = *(const f32x4*)(cb + j0);
        const f32x4 w0g = *(const f32x4*)(cw + DFF + j0), w1g = *(const f32x4*)(cw + UPN + DFF + j0), w2g = *(const f32x4*)(cw + 2 * UPN + DFF + j0), bbg = *(const f32x4*)(cb + DFF + j0);
        float r[4];
#pragma unroll
        for (int e = 0; e < 4; ++e) { const float av = w0a[e] * pa[e] + w1a[e] * ca[e] + w2a[e] * na[e] + bba[e]; const float gv = w0g[e] * pg[e] + w1g[e] * cg_[e] + w2g[e] * ng[e] + bbg[e]; r[e] = av * siluf_(gv); }
        u32x2 o; o[0] = pk_bf16(r[0], r[1]); o[1] = pk_bf16(r[2], r[3]);
        *(u32x2*)(ACT + (size_t)row * DFF + j0) = o;
    }
}

DI void phase_merge_sum(const bf16_t* P, bf16_t* M2, int nrows) {
    const int lane = otid() & 63, wave = otid() >> 6;
    for (int r = obid() * 8 + wave; r < nrows; r += ogrid() * 8) {
        const bf16_t* gp = P + (size_t)r * IN_DIM + C_MG + lane * 8;
        u32x4 v[3][2];
#pragma unroll
        for (int b = 0; b < 3; ++b)
#pragma unroll
            for (int i = 0; i < 2; ++i) v[b][i] = __builtin_nontemporal_load((const u32x4*)(gp + b * 1024 + i * 512));
#pragma unroll
        for (int i = 0; i < 2; ++i) {
            u32x4 o;
#pragma unroll
            for (int j = 0; j < 4; ++j) o[j] = pk_bf16(lo_f(v[0][i][j]) + lo_f(v[1][i][j]) + lo_f(v[2][i][j]), hi_f(v[0][i][j]) + hi_f(v[1][i][j]) + hi_f(v[2][i][j]));
            *(u32x4*)(M2 + (size_t)r * 1024 + i * 512 + lane * 8) = o;
        }
    }
}

#define XB_TMO      128
#define XB_XCNT(j)  (256  + 64 * (j))
#define XB_XSUB(j)  (1280 + 64 * (j))
#define XB_XGEN(j)  (2304 + 64 * (j))
#define XB_TOP      3328
#define XB_TOPGEN   3392
#define XCD_BAR_WORDS 3456
#define XB_SPIN_CAP (1u << 18)
DI unsigned xb_ld(unsigned* p)              { return __hip_atomic_load(p, __ATOMIC_RELAXED, __HIP_MEMORY_SCOPE_AGENT); }
DI unsigned xb_add(unsigned* p, unsigned v) { return __hip_atomic_fetch_add(p, v, __ATOMIC_RELAXED, __HIP_MEMORY_SCOPE_AGENT); }
DI unsigned xb_xcc_id() { return (unsigned)__builtin_amdgcn_s_getreg((3 << 11) | 20) & 0xFu; }
#define XB_SPIN(cond, bar) do { unsigned _sp = 0; while (cond) { __builtin_amdgcn_s_sleep(1); \
    if ((++_sp & 255u) == 0u) { if (xb_ld(&(bar)[XB_TMO])) break; if (_sp > XB_SPIN_CAP) { atomicAdd(&(bar)[XB_TMO], 1u); break; } } } } while (0)
struct XcdBarrier { unsigned* bar; unsigned x; volatile LAS unsigned* st; };
DI XcdBarrier xcd_barrier_post(unsigned* bar, volatile LAS unsigned* st) {
    XcdBarrier b; b.bar = bar; b.x = xb_xcc_id(); b.st = st;
    if (threadIdx.x == 0) (void)xb_add(&bar[XB_XCNT(b.x)], 1u);
    return b;
}
DI void xcd_barrier_complete(unsigned* bar, unsigned x, unsigned& nloc, unsigned& nx) {
    const unsigned G = gridDim.x * gridDim.y * gridDim.z;
    unsigned sum, cnt, mine, sp = 0u;
    for (;;) {
        sum = 0u; cnt = 0u; mine = 0u;
#pragma unroll
        for (unsigned j = 0; j < 16; ++j) { const unsigned c = xb_ld(&bar[XB_XCNT(j)]); sum += c; cnt += (c > 0u) ? 1u : 0u; mine = (j == x) ? c : mine; }
        if (sum == G) break;
        __builtin_amdgcn_s_sleep(1);
        if ((++sp & 255u) == 0u) { if (xb_ld(&bar[XB_TMO])) break; if (sp > XB_SPIN_CAP) { atomicAdd(&bar[XB_TMO], 1u); break; } }
    }
    nloc = mine > 0u ? mine : 1u; nx = cnt > 0u ? cnt : 1u;
}
DI void xcd_barrier(const XcdBarrier& b) {
    asm volatile("s_waitcnt vmcnt(0)" ::: "memory");
    __syncthreads();
    if (threadIdx.x == 0) {
        unsigned* bar = b.bar; asm volatile("" : "+s"(bar));
        __builtin_amdgcn_s_waitcnt(0);
        unsigned nloc = b.st[0], nx = b.st[1];
        if (nloc == 0u) { xcd_barrier_complete(bar, b.x, nloc, nx); b.st[0] = nloc; b.st[1] = nx; }
        const unsigned old = xb_add(&bar[XB_XSUB(b.x)], 1u);
        const unsigned gen = old / nloc;
        if (old + 1u == (gen + 1u) * nloc) {
            __builtin_amdgcn_fence(__ATOMIC_RELEASE, "agent");
            asm volatile("s_waitcnt vmcnt(0)" ::: "memory");
            const unsigned og = xb_add(&bar[XB_TOP], 1u);
            const unsigned tg = og / nx;
            if (og + 1u == (tg + 1u) * nx) xb_add(&bar[XB_TOPGEN], 1u);
            else XB_SPIN(xb_ld(&bar[XB_TOPGEN]) == tg, bar);
            __builtin_amdgcn_fence(__ATOMIC_ACQUIRE, "agent");
            xb_add(&bar[XB_XGEN(b.x)], 1u);
            asm volatile("s_waitcnt vmcnt(0)" ::: "memory");
        } else {
            XB_SPIN(xb_ld(&bar[XB_XGEN(b.x)]) == gen, bar);
            __builtin_amdgcn_fence(__ATOMIC_ACQUIRE, "agent");
            asm volatile("s_waitcnt vmcnt(0)" ::: "memory");
        }
    }
    __syncthreads();
}

constexpr int NS = 12;
constexpr int S_WIN = 0, S_MIX = 1, S_SCAN = 2, S_GLA3 = 3, S_MERGE = 4, S_SUM = 5, S_WO = 6, S_ROWF = 7, S_UP = 8, S_FIX = 9, S_DOWN = 10, S_ROWI = 11;
constexpr int NSTEPS = 2 + DEPTH * NS;


__global__ void __launch_bounds__(NTHR, 2) mk_fwd(Params p) {
    extern __shared__ __attribute__((aligned(16))) unsigned char lds[];
    cg::grid_group grid = cg::this_grid();
    const int ph_lo = p.ph_lo, ph_hi = p.ph_hi;
    volatile LAS unsigned* xst = (volatile LAS unsigned*)((LAS unsigned char*)lds + 131072);
    if (threadIdx.x == 0) { xst[0] = 0u; xst[1] = 0u; }
    __syncthreads();
    const XcdBarrier xbar = xcd_barrier_post((unsigned*)((unsigned char*)PIN(26) + WS_BAR), xst);
    if (ph_lo == 0 && blockIdx.x == gridDim.x - 1) phase_rope((unsigned char*)PIN(26));
#pragma unroll 1
    for (int step = ph_lo; step < ph_hi; ++step) {
        unsigned char* ws = (unsigned char*)PIN(26);
        asm volatile("" : "+s"(ws));
        bool need_sync = true;
        const float* modt = (const float*)(ws + WS_MOD);
        bf16_t* H = (bf16_t*)(ws + WS_H);
        bf16_t* M2 = (bf16_t*)(ws + WS_M2);
        bf16_t* P = (bf16_t*)(ws + WS_P);
        const int l = step < 2 ? 0 : (step - 2) / NS, s = step < 2 ? -1 : (step - 2) % NS;
        const bool last = (l == DEPTH - 1);
        const int Mr = last ? ML : MT;
        const float* modl = modt + (size_t)l * 9 * 6144;
        const bool is_gemm = (s == S_WIN) || (s == S_MERGE) || (s == S_WO) || (s == S_UP) || (s == S_DOWN);
        if (is_gemm) {
            const bf16_t* gA; const bf16_t* gB; int gM, gN, gK, glda = 1024, gldb = 1024, gasplit = 1 << 30, gaoff2 = 0;
            pg8::EpiU E{0, 0, ws};
            if (s == S_WIN) { gA = H; gB = (const bf16_t*)(ws + WS_WIN); gM = MT; gN = IN_PAD; gK = 1024; E.mode = 0; }
            else if (s == S_MERGE) {
                gA = H; gB = (const bf16_t*)(ws + WS_WBR); gldb = 512; gM = Mr; gN = 3072; gK = 512; gasplit = 4; gaoff2 = 1024; E.mode = 2; }
            else if (s == S_WO) { gA = M2; gB = (const bf16_t*)(ws + WS_WO); gM = Mr; gN = 1024; gK = 1024; E.mode = 1; E.aux = 0; }
            else if (s == S_UP) { gA = H; gB = (const bf16_t*)(ws + WS_WUP); gM = Mr; gN = UPN; gK = 1024; E.mode = 3; E.aux = l; }
            else { gA = (const bf16_t*)(ws + WS_P + PO_ACT); glda = DFF; gB = (const bf16_t*)(ws + WS_WDN); gldb = DFF; gM = Mr; gN = 1024; gK = DFF; E.mode = 1; E.aux = 1; }
            EN_GEMM(run_gemm(lds, gA, glda, gB, gldb, gM, gN, gK, E, gasplit, gaoff2);)
            if (s == S_WO && !last) { EN_CVT(phase_convert_weights(ws, l + 1, lds, 0, T0, 32);) }
            else if (s == S_DOWN && !last) { EN_CVT(phase_convert_weights(ws, l + 1, lds, T0, T5, 32);) }
            else if (s == S_MERGE && l > 0) { EN_CVT(phase_convert_weights(ws, l, lds, T5, T6, last ? 0 : 96);) }
#ifdef PROBE_GEMM_S
            if (s == PROBE_GEMM_S) { run_gemm(lds, gA, glda, gB, gldb, gM, gN, gK, E, gasplit, gaoff2); }
#endif
        } else if (step == 0) {
            EN_ADA(phase_ada(PIN(1), PIN(3), PIN(4), PIN(5), ws, lds); __syncthreads();)
#ifdef PROBE_ADA2
            phase_ada(PIN(1), PIN(3), PIN(4), PIN(5), ws, lds); __syncthreads();
#endif
            EN_CVT(phase_convert_weights(ws, 0, lds, 0, T6, 0);)
        } else if (step == 1) {
            EN_ROW(phase_rowpass(ws, MT, PIN(0), PIN(2), nullptr, nullptr, nullptr, false, true, modt, 1, 0, PIN(6));)
        } else if (s == S_MIX) {
#ifdef PROBE_MIX2
          for (int rep = 0; rep < 2; ++rep) {
#endif
            const int nA = NB * 32 * 4, nC = last ? 0 : NB * 2 * 4, nG = NCH * 4, nP = last ? 512 : NCH;
            const int ntot = nA + nC + nG + nP;
            const float* rope = (const float*)(ws + WS_ROPE);
#pragma unroll 1
            for (int it = obid(); it < ntot; it += ogrid()) {
                if (it < nA + nC) {
                    const bool isc = it >= nA; const int j = isc ? it - nA : it;
                    const int h = j & 3, blk = isc ? ((j >> 2) & 1) : ((j >> 2) & 31), b = isc ? (j >> 3) : (j >> 7);
                    EN_ATT(attn_item(P, H, PIN(11) + l * 8, rope, lds, isc, b, blk, h);)
#ifdef PROBE_ATT2
                    attn_item(P, H, PIN(11) + l * 8, rope, lds, isc, b, blk, h);
#endif
                }
                else if (it < nA + nC + nG) { const int j = it - nA - nC; EN_GLA1(gla_pass1_item(ws, PIN(14) + (size_t)l * 4096, PIN(15) + (size_t)l * 256, lds, j >> 2, j & 3);)
#ifdef PROBE_GLA12
                    gla_pass1_item(ws, PIN(14) + (size_t)l * 4096, PIN(15) + (size_t)l * 256, lds, j >> 2, j & 3);
#endif
                }
                else { const int j = it - nA - nC - nG; EN_POOL(pool_item(P, H, PIN(12) + (size_t)l * 4 * 4096, PIN(13) + (size_t)l * 256, lds, j);)
#ifdef PROBE_POOL2
                    pool_item(P, H, PIN(12) + (size_t)l * 4 * 4096, PIN(13) + (size_t)l * 256, lds, j);
#endif
                }
            }
            __syncthreads();
#ifdef PROBE_MIX2
          }
#endif
        }
        else if (s == S_SCAN) { EN_SCAN(phase_gla_scan(ws);) }
        else if (s == S_GLA3) {
            const int nch = last ? 512 : NCH;
#pragma unroll 1
            for (int it = obid(); it < nch * 4; it += ogrid()) { EN_GLA3(gla_pass3_item(ws, PIN(14) + (size_t)l * 4096, PIN(15) + (size_t)l * 256, PIN(16) + (size_t)l * 256, lds, it >> 2, it & 3);)
#ifdef PROBE_GLA32
                    gla_pass3_item(ws, PIN(14) + (size_t)l * 4096, PIN(15) + (size_t)l * 256, PIN(16) + (size_t)l * 256, lds, it >> 2, it & 3);
#endif
                }
            __syncthreads();
        }
        else if (s == S_SUM) { phase_merge_sum(P, M2, Mr); }
        else if (s == S_ROWF) {
#ifdef PROBE_ROW2
            phase_rowpass(ws, Mr, l == 0 ? PIN(0) : PIN(25), l == 0 ? PIN(2) : (const float*)(ws + WS_CTXRES), (const float*)(ws + WS_P), modl + 2 * 1024, PIN(7) + l * 1024,
                                 false, true, modl, 4, 3, PIN(8) + l * 1024);
#endif
            EN_ROW(phase_rowpass(ws, Mr, l == 0 ? PIN(0) : PIN(25), l == 0 ? PIN(2) : (const float*)(ws + WS_CTXRES), (const float*)(ws + WS_P), modl + 2 * 1024, PIN(7) + l * 1024,
                                 true, true, modl, 4, 3, PIN(8) + l * 1024);)
        }
        else if (s == S_FIX) {
            EN_CONV(phase_conv_fixup((const float*)(ws + WS_P + PO_UCH), (bf16_t*)(ws + WS_P + PO_ACT), PIN(22) + (size_t)l * 3 * UPN, PIN(23) + (size_t)l * UPN);)
        }
        else {
            EN_ROW(phase_rowpass(ws, Mr, PIN(25), (const float*)(ws + WS_CTXRES), (const float*)(ws + WS_P + PO_Y2), modl + 5 * 1024, PIN(9) + l * 1024,
                          true, !last, modl + 9 * 6144, 1, 0, PIN(6) + (last ? 0 : (l + 1) * 1024));)
        }
        if (need_sync && step + 1 < ph_hi) {
            if (ph_lo < 0) grid.sync();
            xcd_barrier(xbar);
        }
#ifdef PROBE_SYNC2
        xcd_barrier(xbar); xcd_barrier(xbar);
#endif
    }
}

extern "C" void kernel_launch(void* const* d_in, const int* in_sizes, int n_in, void* d_out, int out_size, void* d_ws, size_t ws_size, hipStream_t stream) {
    static int grid = 0;
    if (!grid) {
        int dev = 0, cus = 0, per_cu = 0;
        (void)hipGetDevice(&dev);
        (void)hipDeviceGetAttribute(&cus, hipDeviceAttributeMultiprocessorCount, dev);
        (void)hipFuncSetAttribute((const void*)mk_fwd, hipFuncAttributeMaxDynamicSharedMemorySize, LDS_BYTES);
        (void)hipOccupancyMaxActiveBlocksPerMultiprocessor(&per_cu, (const void*)mk_fwd, NTHR, LDS_BYTES);
        if (per_cu < 1) per_cu = 1;
        grid = cus * per_cu;
        if (ws_size < WS_END || n_in != 25) { fprintf(stderr, "kernel_launch: ws %zu < %zu or n_in %d\n", ws_size, (size_t)WS_END, n_in); }
    }
    (void)hipMemsetAsync((unsigned char*)d_ws + WS_BAR, 0, 16384, stream);
    Params p{};
    for (int i = 0; i < 25; ++i) p.in[i] = (const float*)d_in[i];
    p.out = (float*)d_out; p.ws = (unsigned char*)d_ws; p.ph_lo = 0; p.ph_hi = NSTEPS;
    void* args[] = {&p};
    hipError_t e = hipLaunchCooperativeKernel((const void*)mk_fwd, dim3(grid), dim3(NTHR), args, LDS_BYTES, stream);
    if (e != hipSuccess) fprintf(stderr, "cooperative launch failed: %s (grid %d)\n", hipGetErrorString(e), grid);
}
```

```cpp
#include <hip/hip_runtime.h>
#include <hip/hip_cooperative_groups.h>
#include <cstdio>
namespace cg = cooperative_groups;

#ifndef DIS_GEMM
#define EN_GEMM(...) __VA_ARGS__
#else
#define EN_GEMM(...)
#endif
#ifndef DIS_ADA
#define EN_ADA(...) __VA_ARGS__
#else
#define EN_ADA(...)
#endif
#ifndef DIS_CVT
#define EN_CVT(...) __VA_ARGS__
#else
#define EN_CVT(...)
#endif
#ifndef DIS_ROW
#define EN_ROW(...) __VA_ARGS__
#else
#define EN_ROW(...)
#endif
#ifndef DIS_G1
#define EN_G1(...) __VA_ARGS__
#else
#define EN_G1(...)
#endif
#ifndef DIS_ATT
#define EN_ATT(...) __VA_ARGS__
#else
#define EN_ATT(...)
#endif
#ifndef DIS_GLA1
#define EN_GLA1(...) __VA_ARGS__
#else
#define EN_GLA1(...)
#endif
#ifndef DIS_POOL
#define EN_POOL(...) __VA_ARGS__
#else
#define EN_POOL(...)
#endif
#ifndef DIS_SCAN
#define EN_SCAN(...) __VA_ARGS__
#else
#define EN_SCAN(...)
#endif
#ifndef DIS_GLA3
#define EN_GLA3(...) __VA_ARGS__
#else
#define EN_GLA3(...)
#endif
#ifndef DIS_GM
#define EN_GM(...) __VA_ARGS__
#else
#define EN_GM(...)
#endif
#ifndef DIS_GO
#define EN_GO(...) __VA_ARGS__
#else
#define EN_GO(...)
#endif
#ifndef DIS_GU
#define EN_GU(...) __VA_ARGS__
#else
#define EN_GU(...)
#endif
#ifndef DIS_CONV
#define EN_CONV(...) __VA_ARGS__
#else
#define EN_CONV(...)
#endif
#ifndef DIS_GD
#define EN_GD(...) __VA_ARGS__
#else
#define EN_GD(...)
#endif
#define LAS __attribute__((address_space(3)))
#define DI __device__ __forceinline__
typedef unsigned short bf16_t;
typedef short bf16x8 __attribute__((ext_vector_type(8)));
typedef short s16x4 __attribute__((ext_vector_type(4)));
typedef float f32x4 __attribute__((ext_vector_type(4)));
typedef float f32x2 __attribute__((ext_vector_type(2)));
typedef unsigned u32x4 __attribute__((ext_vector_type(4)));
typedef unsigned u32x2 __attribute__((ext_vector_type(2)));

constexpr int DM = 1024, NB = 8, SEQ = 4096, DEPTH = 4, CTXL = 256;
constexpr int ML = NB * SEQ, MC = NB * CTXL, MT = ML + MC;
constexpr int IN_DIM = 4896, IN_PAD = 5120, DFF = 2816, UPN = 5632;
constexpr int C_AQ = 0, C_AK = 512, C_AV = 640, C_PU = 768, C_GQ = 1024, C_GK = 1152, C_GV = 1280, C_GR = 1536, C_GLR = 1792, C_MG = 1824;
constexpr int NCH = MT / 64;
constexpr float EPS = 1e-6f;
constexpr int NTHR = 512;
constexpr int LDS_BYTES = 131072 + 64 + 8192 + 4096;

constexpr size_t WS_CTXRES = 0;
constexpr size_t WS_MOD = WS_CTXRES + (size_t)MC * DM * 4;
constexpr size_t WS_ROPE = WS_MOD + (size_t)DEPTH * 9 * 6144 * 4;
constexpr size_t WS_GDEC = WS_ROPE + 64 * 16 * 2 * 4;
constexpr size_t WS_WIN = WS_GDEC + (size_t)NCH * 4 * 2 * 32 * 4;
constexpr size_t WS_WBR = WS_WIN + (size_t)IN_PAD * 1024 * 2;
constexpr size_t WS_WO = WS_WBR + (size_t)3072 * 512 * 2;
constexpr size_t WS_WUP = WS_WO + (size_t)1024 * 1024 * 2;
constexpr size_t WS_WDN = WS_WUP + (size_t)UPN * 1024 * 2;
constexpr size_t WS_H = WS_WDN + (size_t)1024 * DFF * 2;
constexpr size_t WS_M2 = WS_H + (size_t)MT * 1024 * 2;
constexpr size_t WS_P = WS_M2 + (size_t)MT * 1024 * 2;
constexpr size_t WS_BAR = WS_P + (size_t)MT * IN_DIM * 2;
constexpr size_t WS_END = WS_BAR + 16384;
constexpr size_t PO_ACT = 0;
constexpr size_t PO_UCH = (size_t)MT * DFF * 2;
constexpr size_t PO_Y2 = PO_UCH;
static_assert(PO_Y2 + (size_t)MT * 1024 * 4 <= (size_t)MT * IN_DIM * 2, "P region too small");
static_assert(PO_UCH + (size_t)10240 * UPN * 2 <= (size_t)MT * IN_DIM * 2, "P region too small");

struct Params { const float* in[25]; float* out; unsigned char* ws; int ph_lo, ph_hi; };
typedef const float* const volatile __attribute__((address_space(4))) * KargTbl;
#define PIN(i) (((KargTbl)__builtin_amdgcn_kernarg_segment_ptr())[i])

DI float bf2f(bf16_t b) { return __uint_as_float(((unsigned)b) << 16); }
DI bf16_t f2bf(float f) { unsigned u = __float_as_uint(f); u += 0x7FFFu + ((u >> 16) & 1u); return (bf16_t)(u >> 16); }
DI unsigned pk_bf16(float lo, float hi) { unsigned r; asm("v_cvt_pk_bf16_f32 %0, %1, %2" : "=v"(r) : "v"(lo), "v"(hi)); return r; }
typedef __bf16 bf16x2v __attribute__((ext_vector_type(2)));
DI unsigned pk_bf16_mfma(float lo, float hi) { const f32x2 v = {lo, hi}; return __builtin_bit_cast(unsigned, __builtin_convertvector(v, bf16x2v)); }
DI float lo_f(unsigned w) { return __uint_as_float(w << 16); }
DI float hi_f(unsigned w) { return __uint_as_float(w & 0xffff0000u); }
DI float sigmoidf_(float x) { return __builtin_amdgcn_rcpf(1.f + __expf(-x)); }
DI float siluf_(float x) { return x * __builtin_amdgcn_rcpf(1.f + __expf(-x)); }
DI int obid() { int t = blockIdx.x; asm volatile("" : "+s"(t)); return t; }
DI int ogrid() { int t = gridDim.x; asm volatile("" : "+s"(t)); return t; }
DI int otid() { int t = threadIdx.x; asm volatile("" : "+v"(t)); return t; }
DI float shx(float v, int m, int lane) { return __int_as_float(__builtin_amdgcn_ds_bpermute((lane ^ m) << 2, __float_as_int(v))); }
DI float wave_sum(float v) {
    const int lane = otid() & 63;
#pragma unroll
    for (int o = 32; o >= 1; o >>= 1) v += shx(v, o, lane);
    return v;
}

namespace pg8 {
constexpr int BM = 256, BK = 64, HALF = 128, HTB = HALF * BK * 2, STAGE_BYTES = 8 * HTB, NXCD = 8, WGM = 8;
DI int lds_byte(int r, int c) { const int st = (r >> 4) * 2 + (c >> 5), rr = r & 15, cc = c & 31, ob = rr * 64 + cc * 2; return st * 1024 + (ob ^ (((ob >> 9) & 1) << 5)); }
DI void stage_rc(int b, int& R, int& C) { const int st = b / 1024, sb = b % 1024, swz = sb ^ (((sb >> 9) & 1) << 5); R = (st >> 1) * 16 + swz / 64; C = (st & 1) * 32 + (swz % 64) / 2; }
DI int perm32(int rho) { const int n = rho >> 4, i = rho & 15; return 8 * (i >> 2) + 4 * n + (i & 3); }
struct Unit { int pm, pn; };
struct Gemm { const bf16_t* A; const bf16_t* Bt; int M, N, K, lda, ldb, asplit, aoff2; };
struct StaticOrder {
    int nM, nN, nwg, G, c;
    DI void init(int M, int N, int G_, int c_) { nM = M / BM; nN = N / BM; nwg = nM * nN; G = G_; c = c_; }
    DI bool next(int i, Unit& u) const {
        const long L = (long)i * G + c; if (L >= nwg) return false;
        int wgid = (int)L; { const int q = nwg / NXCD, r = nwg % NXCD, xcd = wgid % NXCD, off = wgid / NXCD; wgid = (xcd < r ? xcd * (q + 1) : r * (q + 1) + (xcd - r) * q) + off; }
        const int nig = WGM * nN, gid = wgid / nig, fm = gid * WGM, gsz = (nM - fm) < WGM ? (nM - fm) : WGM;
        u.pm = fm + ((wgid % nig) % gsz); u.pn = (wgid % nig) / gsz; return true;
    }
};

template <class Epi>
DI void gemm_phase(LAS unsigned char* lds, const Gemm g, const StaticOrder& S, const Epi& E) {
    const int tid = otid(), wid = __builtin_amdgcn_readfirstlane(tid >> 6), lane = tid & 63, wr = wid >> 2, wc = wid & 3, fr = lane & 15, fq = lane >> 4;
    const int K = g.K, nt = K / BK;
    unsigned voffA[2], voffB[2];
#pragma unroll
    for (int i = 0; i < 2; ++i) { int R, C; stage_rc(tid * 16 + i * 8192, R, C); const int Rb = Epi::PERM ? ((R & ~31) + perm32(R & 31)) : R;
        voffA[i] = (unsigned)(R * g.lda + C) * 2u; voffB[i] = (unsigned)(Rb * g.ldb + C) * 2u; }
    const size_t kstep = (size_t)(BK * 2);
    const size_t hstepA = (size_t)HALF * g.lda * 2, hstepB = (size_t)HALF * g.ldb * 2;
    const size_t tstepA = 2 * hstepA, tstepB = 2 * hstepB;
    const unsigned ldsw = (unsigned)wid * 1024u;
    const int aoff = lds_byte(wr * 64 + fr, fq * 8), boff = lds_byte(wc * 32 + fr, fq * 8);
#define PG8_SA(b, h) (((b) * 2 + (h)) * HTB)
#define PG8_SB(b, h) ((4 + (b) * 2 + (h)) * HTB)
#define PG8_STAGE(bufoff, gbase, voff) do { _Pragma("unroll") for (int _i = 0; _i < 2; ++_i) \
        __builtin_amdgcn_global_load_lds((const unsigned*)((const char*)(gbase) + (voff)[_i]), (LAS unsigned*)(lds + (bufoff) + ldsw + _i * 8192), 16, 0, 0); } while (0)
#define PG8_LDA(dst, b, h) do { _Pragma("unroll") for (int m = 0; m < 4; ++m) _Pragma("unroll") for (int k = 0; k < 2; ++k) dst[m][k] = *(const LAS bf16x8*)(lds + PG8_SA(b, h) + aoff + m * 2048 + k * 1024); } while (0)
#define PG8_LDB(dst, b, h) do { _Pragma("unroll") for (int n = 0; n < 2; ++n) _Pragma("unroll") for (int k = 0; k < 2; ++k) dst[n][k] = *(const LAS bf16x8*)(lds + PG8_SB(b, h) + boff + n * 2048 + k * 1024); } while (0)
#define PG8_MMA(ai, bj, At, Bt) do { __builtin_amdgcn_s_setprio(1); _Pragma("unroll") for (int m = 0; m < 4; ++m) _Pragma("unroll") for (int n = 0; n < 2; ++n) _Pragma("unroll") for (int k = 0; k < 2; ++k) \
        acc[ai][bj][m][n] = __builtin_amdgcn_mfma_f32_16x16x32_bf16(Bt[n][k], At[m][k], acc[ai][bj][m][n], 0, 0, 0); __builtin_amdgcn_s_setprio(0); } while (0)
#define PG8_WAIT_V(n) asm volatile("s_waitcnt vmcnt(" #n ")" ::: "memory")
#define PG8_WAIT_L(n) asm volatile("s_waitcnt lgkmcnt(" #n ")" ::: "memory")
#define PG8_BAR __builtin_amdgcn_s_barrier()
#define PG8_SCHED __builtin_amdgcn_sched_barrier(0)
    Unit cur, nxt; int ui = 0;
    if (!S.next(0, cur)) return;
    f32x4 acc[2][2][4][2];
#pragma unroll
    for (int a = 0; a < 2; ++a)
#pragma unroll
        for (int b = 0; b < 2; ++b)
#pragma unroll
            for (int m = 0; m < 4; ++m)
#pragma unroll
                for (int n = 0; n < 2; ++n) acc[a][b][m][n] = (f32x4){0.f, 0.f, 0.f, 0.f};
    bf16x8 At[4][2], B0[2][2], B1[2][2];
    const bool mrg = (g.asplit == 4);
#define PG8_AOFS(u) (mrg ? ((u).pn >= 8 ? 1536 : ((u).pn >= 4 ? 1024 : 0)) : 0)
#define PG8_BOFS(u) ((mrg && (u).pn >= 8) ? 512 : 0)
#define PG8_NT(u) ((mrg && (u).pn >= 4) ? 4 : nt)
    const char* cA = (const char*)g.A + (size_t)cur.pm * tstepA + PG8_AOFS(cur); const char* cB = (const char*)g.Bt + (size_t)cur.pn * tstepB + PG8_BOFS(cur);
    PG8_STAGE(PG8_SB(0, 0), cB, voffB); PG8_STAGE(PG8_SA(0, 0), cA, voffA); PG8_STAGE(PG8_SB(0, 1), cB + hstepB, voffB); PG8_STAGE(PG8_SA(0, 1), cA + hstepA, voffA);
    if (wr == 1) PG8_BAR;
    PG8_WAIT_V(4); PG8_BAR;
    PG8_STAGE(PG8_SB(1, 0), cB + kstep, voffB); PG8_STAGE(PG8_SA(1, 0), cA + kstep, voffA); PG8_STAGE(PG8_SB(1, 1), cB + hstepB + kstep, voffB);
    PG8_WAIT_V(6); PG8_BAR;
    for (;;) {
        const bool has_next = S.next(ui + 1, nxt);
        const char* nA = has_next ? (const char*)g.A + (size_t)nxt.pm * tstepA + PG8_AOFS(nxt) : cA; const char* nB = has_next ? (const char*)g.Bt + (size_t)nxt.pn * tstepB + PG8_BOFS(nxt) : cB;
        const int ntc = PG8_NT(cur);
        for (int t = 0; t < ntc; t += 2) {
            const bool last = (t == ntc - 2);
            const char* a1 = cA + (size_t)(t + 1) * kstep;
            const char* a2 = last ? nA : cA + (size_t)(t + 2) * kstep; const char* b2 = last ? nB : cB + (size_t)(t + 2) * kstep;
            const char* a3 = a2 + kstep; const char* b3 = b2 + kstep;
            PG8_LDB(B0, 0, 0); PG8_SCHED; PG8_LDA(At, 0, 0); PG8_STAGE(PG8_SA(1, 1), a1 + hstepA, voffA);
            PG8_WAIT_L(8); PG8_BAR; PG8_WAIT_L(0); PG8_MMA(0, 0, At, B0); PG8_BAR; PG8_SCHED;
            PG8_LDB(B1, 0, 1); PG8_STAGE(PG8_SB(0, 0), b2, voffB);
            PG8_BAR; PG8_WAIT_L(0); PG8_MMA(0, 1, At, B1); PG8_BAR;
            PG8_LDA(At, 0, 1); PG8_STAGE(PG8_SA(0, 0), a2, voffA);
            PG8_BAR; PG8_WAIT_L(0); PG8_MMA(1, 0, At, B0); PG8_BAR; PG8_SCHED;
            PG8_STAGE(PG8_SB(0, 1), b2 + hstepB, voffB);
            PG8_WAIT_V(6); PG8_BAR; PG8_MMA(1, 1, At, B1); PG8_BAR;
            PG8_LDB(B0, 1, 0); PG8_SCHED; PG8_LDA(At, 1, 0); PG8_STAGE(PG8_SA(0, 1), a2 + hstepA, voffA);
            PG8_WAIT_L(8); PG8_BAR; PG8_WAIT_L(0); PG8_MMA(0, 0, At, B0); PG8_BAR; PG8_SCHED;
            PG8_LDB(B1, 1, 1); PG8_STAGE(PG8_SB(1, 0), b3, voffB);
            PG8_BAR; PG8_WAIT_L(0); PG8_MMA(0, 1, At, B1); PG8_BAR;
            PG8_LDA(At, 1, 1); PG8_STAGE(PG8_SA(1, 0), a3, voffA);
            PG8_BAR; PG8_WAIT_L(0); PG8_MMA(1, 0, At, B0); PG8_BAR; PG8_SCHED;
            PG8_STAGE(PG8_SB(1, 1), b3 + hstepB, voffB);
            PG8_WAIT_V(6); PG8_BAR; PG8_MMA(1, 1, At, B1); PG8_BAR;
        }
        {
            int wr2 = wr, wc2 = wc; Unit cu2 = cur; Epi E2 = E;
            asm volatile("" : "+s"(wr2), "+s"(wc2), "+s"(cu2.pm), "+s"(cu2.pn), "+s"(E2.ws), "+s"(E2.aux));
            const int ln2 = otid() & 63;
            const int fr2 = ln2 & 15, fq2 = ln2 >> 4;
            E2(acc, cu2, wr2, wc2, fr2, fq2, lds);
        }
        if (!has_next) break;
#pragma unroll
        for (int a = 0; a < 2; ++a)
#pragma unroll
            for (int b = 0; b < 2; ++b)
#pragma unroll
                for (int m = 0; m < 4; ++m)
#pragma unroll
                    for (int n = 0; n < 2; ++n) acc[a][b][m][n] = (f32x4){0.f, 0.f, 0.f, 0.f};
        cur = nxt; cA = nA; cB = nB; ++ui;
    }
    PG8_WAIT_V(0);
    if (wr == 0) PG8_BAR;
    PG8_BAR;
#undef PG8_AOFS
#undef PG8_BOFS
#undef PG8_NT
#undef PG8_SA
#undef PG8_SB
#undef PG8_STAGE
#undef PG8_LDA
#undef PG8_LDB
#undef PG8_MMA
#undef PG8_WAIT_V
#undef PG8_WAIT_L
#undef PG8_BAR
#undef PG8_SCHED
}

struct EpiU {
    static constexpr bool PERM = true;
    int mode; int aux; unsigned char* ws;
    DI void operator()(const f32x4 (&acc)[2][2][4][2], const Unit& u, int wr, int wc, int fr, int fq, LAS unsigned char* lds) const {
        void* const out = (mode == 0) ? (void*)(ws + WS_P) : (mode == 1) ? (void*)(ws + WS_P + (aux ? PO_Y2 : 0)) : (mode == 2) ? (void*)(ws + WS_M2) : (void*)(ws + WS_P + PO_ACT);
        const int ldc = (mode == 0) ? IN_DIM : 1024, ncols = IN_DIM, br = aux;
        const bf16_t* const P = (const bf16_t*)(ws + WS_P);
        const float* const cw = PIN(22) + (size_t)aux * 3 * UPN; const float* const cb = PIN(23) + (size_t)aux * UPN;
        float* const edge = (float*)(ws + WS_P + PO_UCH);
        const int row0 = u.pm * BM + wr * 64 + fr, col0 = u.pn * BM + wc * 32 + 8 * fq;
        const unsigned rl0 = (unsigned)(wr * 64 + fr), cl0 = (unsigned)(wc * 32 + 8 * fq);
        if (mode == 0) {
            bf16_t* Ob = (bf16_t*)out + (size_t)u.pm * BM * ldc + u.pn * BM;
#pragma unroll
            for (int ai = 0; ai < 2; ++ai)
#pragma unroll
                for (int m = 0; m < 4; ++m)
#pragma unroll
                    for (int bj = 0; bj < 2; ++bj) { const int col = col0 + bj * HALF;
                        const f32x4 v0 = acc[ai][bj][m][0], v1 = acc[ai][bj][m][1];
                        u32x4 o; o[0] = pk_bf16_mfma(v0[0], v0[1]); o[1] = pk_bf16_mfma(v0[2], v0[3]); o[2] = pk_bf16_mfma(v1[0], v1[1]); o[3] = pk_bf16_mfma(v1[2], v1[3]);
                        if (col < ncols) *(u32x4*)(Ob + ((rl0 + ai * HALF + m * 16) * (unsigned)IN_DIM + cl0 + bj * HALF)) = o; }
        } else if (mode == 1) {
            float* Cb = (float*)out + (size_t)u.pm * BM * 1024 + u.pn * BM;
#pragma unroll
            for (int ai = 0; ai < 2; ++ai)
#pragma unroll
                for (int m = 0; m < 4; ++m)
#pragma unroll
                    for (int bj = 0; bj < 2; ++bj) { float* rp = Cb + ((rl0 + ai * HALF + m * 16) * 1024u + cl0 + bj * HALF);
                        *(f32x4*)rp = acc[ai][bj][m][0]; *(f32x4*)(rp + 4) = acc[ai][bj][m][1]; }
        } else if (mode == 3) {
            bf16_t* ACTb = (bf16_t*)out + (size_t)u.pm * 256 * DFF + u.pn * 128;
            LAS float* XR = (LAS float*)(lds + 131072 + 64);
            LAS float* CWL = XR + 2048;
            const int lane = (fq << 4) | fr;
            const int cl = wc * 32 + 8 * fq;
            if (fr == 0) {
#pragma unroll
                for (int ai = 0; ai < 2; ++ai)
#pragma unroll
                    for (int bj = 0; bj < 2; ++bj)
#pragma unroll
                        for (int n = 0; n < 2; ++n) *(LAS f32x4*)(XR + ((((wr * 2 + ai) * 2 + 0) * 2 + bj) * 128 + cl + 4 * n)) = acc[ai][bj][0][n];
            }
            if (fr == 15) {
#pragma unroll
                for (int ai = 0; ai < 2; ++ai)
#pragma unroll
                    for (int bj = 0; bj < 2; ++bj)
#pragma unroll
                        for (int n = 0; n < 2; ++n) *(LAS f32x4*)(XR + ((((wr * 2 + ai) * 2 + 1) * 2 + bj) * 128 + cl + 4 * n)) = acc[ai][bj][3][n];
            }
            {
                float* EGb = edge + (size_t)u.pm * 4 * UPN + u.pn * 256;
                if (wr == 0 && fr < 2) {
#pragma unroll
                    for (int bj = 0; bj < 2; ++bj)
#pragma unroll
                        for (int n = 0; n < 2; ++n) *(f32x4*)(EGb + (unsigned)(fr * UPN + cl + bj * 128 + 4 * n)) = acc[0][bj][0][n];
                }
                if (wr == 1 && fr >= 14) {
#pragma unroll
                    for (int bj = 0; bj < 2; ++bj)
#pragma unroll
                        for (int n = 0; n < 2; ++n) *(f32x4*)(EGb + (unsigned)((fr - 12) * UPN + cl + bj * 128 + 4 * n)) = acc[1][bj][3][n];
                }
            }
            {
                const int tid = (((wr << 2) | wc) << 6) | lane;
#pragma unroll
                for (int i = 0; i < 2; ++i) {
                    const int idx = tid + 512 * i, pp = idx >> 7, c = idx & 127;
                    const int srcc = ((pp >= 4) ? DFF : 0) + u.pn * 128 + c;
                    CWL[idx] = ((pp & 3) == 3) ? cb[srcc] : cw[(pp & 3) * UPN + srcc];
                }
            }
            asm volatile("s_waitcnt vmcnt(0) lgkmcnt(0)" ::: "memory");
            __builtin_amdgcn_s_barrier(); __builtin_amdgcn_s_barrier();
            asm volatile("" ::: "memory");
#pragma unroll
            for (int ai = 0; ai < 2; ++ai) {
                const bool hasp = !(wr == 0 && ai == 0), hasn = !(wr == 1 && ai == 1);
                const int pw = (wr == 1) ? 0 : 1, pa = (wr == 1) ? ai : 0;
                const int nw = (wr == 0) ? 1 : 0, na = (wr == 0) ? ai : 1;
                const LAS float* xp = XR + ((((pw * 2 + pa) * 2 + 1) * 2 + 0) * 128 + cl);
                const LAS float* xn = XR + ((((nw * 2 + na) * 2 + 0) * 2 + 0) * 128 + cl);
#pragma unroll
                for (int n = 0; n < 2; ++n) {
                    float o[4][4];
#pragma unroll
                    for (int e = 0; e < 4; ++e) {
                        const LAS float* cwp = CWL + cl + 4 * n + e;
                        const float xpa = hasp ? xp[4 * n + e] : 0.f, xpg = hasp ? xp[128 + 4 * n + e] : 0.f;
                        const float xna = hasn ? xn[4 * n + e] : 0.f, xng = hasn ? xn[128 + 4 * n + e] : 0.f;
                        float ap[4], gp[4], an[4], gn[4];
#pragma unroll
                        for (int m = 0; m < 4; ++m) {
                            const float ca = acc[ai][0][m][n][e], cg2 = acc[ai][1][m][n][e];
                            const float oa_p = (fr == 15) ? acc[ai][0][m == 0 ? 0 : m - 1][n][e] : ca, og_p = (fr == 15) ? acc[ai][1][m == 0 ? 0 : m - 1][n][e] : cg2;
                            const float oa_n = (fr == 0) ? acc[ai][0][m == 3 ? 3 : m + 1][n][e] : ca, og_n = (fr == 0) ? acc[ai][1][m == 3 ? 3 : m + 1][n][e] : cg2;
                            ap[m] = __int_as_float(__builtin_amdgcn_mov_dpp(__float_as_int(oa_p), 0x121, 0xF, 0xF, false));
                            gp[m] = __int_as_float(__builtin_amdgcn_mov_dpp(__float_as_int(og_p), 0x121, 0xF, 0xF, false));
                            an[m] = __int_as_float(__builtin_amdgcn_mov_dpp(__float_as_int(oa_n), 0x12F, 0xF, 0xF, false));
                            gn[m] = __int_as_float(__builtin_amdgcn_mov_dpp(__float_as_int(og_n), 0x12F, 0xF, 0xF, false));
                        }
                        ap[0] = (fr == 0) ? xpa : ap[0]; gp[0] = (fr == 0) ? xpg : gp[0];
                        an[3] = (fr == 15) ? xna : an[3]; gn[3] = (fr == 15) ? xng : gn[3];
                        const float w0a = cwp[0], w1a = cwp[128], w2a = cwp[256], bba = cwp[384];
                        const float w0g = cwp[512], w1g = cwp[640], w2g = cwp[768], bbg = cwp[896];
#pragma unroll
                        for (int m = 0; m < 4; ++m) {
                            const float av = w0a * ap[m] + w1a * acc[ai][0][m][n][e] + w2a * an[m] + bba;
                            const float gv = w0g * gp[m] + w1g * acc[ai][1][m][n][e] + w2g * gn[m] + bbg;
                            o[m][e] = av * siluf_(gv);
                        }
                        __builtin_amdgcn_sched_barrier(0);
                    }
#pragma unroll
                    for (int m = 0; m < 4; ++m) {
                        u32x2 ov; ov[0] = pk_bf16(o[m][0], o[m][1]); ov[1] = pk_bf16(o[m][2], o[m][3]);
                        *(u32x2*)(ACTb + (unsigned)((wr * 64 + fr + ai * HALF + m * 16) * DFF + cl + 4 * n)) = ov;
                    }
                    __builtin_amdgcn_sched_barrier(0);
                }
            }
        } else {
            bf16_t* Gb = (bf16_t*)(ws + WS_P) + C_MG + (size_t)u.pm * BM * IN_DIM + u.pn * BM;
#pragma unroll
            for (int ai = 0; ai < 2; ++ai)
#pragma unroll
                for (int m = 0; m < 4; ++m)
#pragma unroll
                    for (int bj = 0; bj < 2; ++bj) {
                        bf16_t* gp = Gb + ((rl0 + ai * HALF + m * 16) * (unsigned)IN_DIM + cl0 + bj * HALF);
                        const u32x4 gv = *(const u32x4*)gp;
                        const f32x4 v0 = acc[ai][bj][m][0], v1 = acc[ai][bj][m][1];
                        u32x4 o;
                        o[0] = pk_bf16(v0[0] * sigmoidf_(lo_f(gv[0])), v0[1] * sigmoidf_(hi_f(gv[0]))); o[1] = pk_bf16(v0[2] * sigmoidf_(lo_f(gv[1])), v0[3] * sigmoidf_(hi_f(gv[1])));
                        o[2] = pk_bf16(v1[0] * sigmoidf_(lo_f(gv[2])), v1[1] * sigmoidf_(hi_f(gv[2]))); o[3] = pk_bf16(v1[2] * sigmoidf_(lo_f(gv[3])), v1[3] * sigmoidf_(hi_f(gv[3])));
                        *(u32x4*)gp = o; }
        }
    }
};
}

template <class Epi>
DI void run_gemm(unsigned char* lds, const bf16_t* A, int lda, const bf16_t* Bt, int ldb, int M, int N, int K, const Epi& E, int asplit = 1 << 30, int aoff2 = 0) {
    pg8::Gemm g{A, Bt, M, N, K, lda, ldb, asplit, aoff2};
    pg8::StaticOrder S; S.init(M, N, ogrid(), obid());
    pg8::gemm_phase<Epi>((LAS unsigned char*)lds, g, S, E);
}

DI void sincos_acc(float x, float& c, float& s) {
    const double xd = (double)x;
    const double kd = __builtin_rint(xd * 0.63661977236758134308);
    double r = __builtin_fma(-kd, 1.57079632679489655800, xd);
    r = __builtin_fma(-kd, 6.12323399573676603587e-17, r);
    const double r2 = r * r;
    const double sp = r * (1.0 + r2 * (-1.0 / 6 + r2 * (1.0 / 120 + r2 * (-1.0 / 5040 + r2 * (1.0 / 362880 + r2 * (-1.0 / 39916800 + r2 * (1.0 / 6227020800.0)))))));
    const double cp = 1.0 + r2 * (-0.5 + r2 * (1.0 / 24 + r2 * (-1.0 / 720 + r2 * (1.0 / 40320 + r2 * (-1.0 / 3628800 + r2 * (1.0 / 479001600.0 + r2 * (-1.0 / 87178291200.0)))))));
    const int k = ((int)kd) & 3;
    const double cc = (k == 0) ? cp : (k == 1) ? -sp : (k == 2) ? -cp : sp;
    const double ss = (k == 0) ? sp : (k == 1) ? cp : (k == 2) ? -sp : -cp;
    c = (float)cc; s = (float)ss;
}

DI void phase_rope(unsigned char* ws) {
    const int tid = otid();
    {
        float* rt = (float*)(ws + WS_ROPE);
        for (int i = tid; i < 1024; i += NTHR) {
            const int pos = i >> 4, fi = i & 15;
            const double b4 = ((fi & 3) == 0) ? 1.0 : ((fi & 3) == 1) ? 0.56234132519034908 : ((fi & 3) == 2) ? 0.31622776601683794 : 0.17782794100389228;
            const double p10 = ((fi >> 2) == 0) ? 1.0 : ((fi >> 2) == 1) ? 0.1 : ((fi >> 2) == 2) ? 0.01 : 0.001;
            const float inv = (float)(b4 * p10);
            const float ang = (float)pos * inv;
            float c, s; sincos_acc(ang, c, s);
            rt[2 * i] = c; rt[2 * i + 1] = s;
        }
    }
}

DI const float* p_wada(const float* w_ada, int l) { return w_ada + (size_t)l * 1024 * 6144; }
DI void phase_ada(const float* c_in, const float* cctx_in, const float* w_ada, const float* b_ada, unsigned char* ws, unsigned char* lds) {
    float* sc = (float*)lds;
    float* red = sc + 9 * 1024;
    const int tid = otid();
    float* modt = (float*)(ws + WS_MOD);
    for (int i = tid; i < 9 * 1024; i += NTHR) { const int r = i >> 10, k = i & 1023; const float v = r < 8 ? c_in[r * 1024 + k] : cctx_in[k]; sc[i] = siluf_(v); }
    __syncthreads();
    for (int it = obid(); it < DEPTH * 48; it += ogrid()) {
        const int l = it / 48, cgp = it % 48;
        const int c4 = (tid & 31) * 4, kg = tid >> 5;
        const float* W = p_wada(w_ada, l) + cgp * 128 + c4;
        float acc[9][4];
#pragma unroll
        for (int r = 0; r < 9; ++r)
#pragma unroll
            for (int j = 0; j < 4; ++j) acc[r][j] = 0.f;
#pragma unroll 8
        for (int k = kg * 64; k < kg * 64 + 64; ++k) {
            const f32x4 w = __builtin_nontemporal_load((const f32x4*)(W + (size_t)k * 6144));
#pragma unroll
            for (int r = 0; r < 9; ++r) { const float sv = sc[r * 1024 + k]; acc[r][0] += sv * w[0]; acc[r][1] += sv * w[1]; acc[r][2] += sv * w[2]; acc[r][3] += sv * w[3]; }
        }
#pragma unroll
        for (int r = 0; r < 9; ++r)
#pragma unroll
            for (int j = 0; j < 4; ++j) red[(kg * 128 + c4 + j) * 9 + r] = acc[r][j];
        __syncthreads();
        if (tid < 128) {
            const int col = cgp * 128 + tid;
            const float bb = b_ada[l * 6144 + col];
#pragma unroll
            for (int r = 0; r < 9; ++r) {
                float s = 0.f;
#pragma unroll
                for (int g = 0; g < 16; ++g) s += red[(g * 128 + tid) * 9 + r];
                modt[((size_t)l * 9 + r) * 6144 + col] = s + bb;
            }
        }
        __syncthreads();
    }
}

DI void tr_tile(const float* src, int src_ld, int k0, int n0, int mode, bf16_t* dst, int dst_ld, int dst_koff, float* tile) {
    const int tid = otid();
    {   const int nn4 = (tid & 15) * 4; const int np = n0 + nn4;
        int col = np; bool valid = true;
        if (mode == 1) valid = np < IN_DIM;
        if (mode == 3) valid = false;
        if (mode == 2) { const int pn = np >> 8, bj = (np >> 7) & 1, jj = np & 127; col = bj * DFF + pn * 128 + jj; }
#pragma unroll
        for (int i = 0; i < 2; ++i) { const int kk = (tid >> 4) + 32 * i;
            f32x4 v = (f32x4){0.f, 0.f, 0.f, 0.f};
            if (valid) v = __builtin_nontemporal_load((const f32x4*)(src + (size_t)(k0 + kk) * src_ld + col));
            tile[kk * 65 + nn4] = v[0]; tile[kk * 65 + nn4 + 1] = v[1]; tile[kk * 65 + nn4 + 2] = v[2]; tile[kk * 65 + nn4 + 3] = v[3]; }
    }
    __syncthreads();
    {   const int nn = tid >> 3, ks = (tid & 7) * 8;
        float v[8];
#pragma unroll
        for (int j = 0; j < 8; ++j) v[j] = tile[(ks + j) * 65 + nn];
        u32x4 o; o[0] = pk_bf16(v[0], v[1]); o[1] = pk_bf16(v[2], v[3]); o[2] = pk_bf16(v[4], v[5]); o[3] = pk_bf16(v[6], v[7]);
        *(u32x4*)(dst + (size_t)(n0 + nn) * dst_ld + dst_koff + k0 + ks) = o;
    }
    __syncthreads();
}

constexpr int T0 = 1280, T1 = T0 + 128, T2 = T1 + 64, T2b = T2 + 64, T2c = T2b + 64, T3 = T2c + 64, T4 = T3 + 256, T5 = T4 + 1408, T6 = T5 + 704;
DI void phase_convert_weights(unsigned char* ws, int l, unsigned char* lds, int t_lo, int t_hi, int bid_off) {
    float* tile = (float*)lds;
    if (bid_off > ogrid() / 2) bid_off = 0;
    if (obid() < bid_off) return;
    for (int it = t_lo + (obid() - bid_off); it < t_hi; it += ogrid() - bid_off) {
        if (it < T0) { const int nt = it / 16, kt = it % 16;
            tr_tile(PIN(10) + (size_t)l * 1024 * IN_DIM, IN_DIM, kt * 64, nt * 64, 1, (bf16_t*)(ws + WS_WIN), 1024, 0, tile);
        } else if (it < T1) { const int j = it - T0, nt = j / 8, kt = j % 8;
            tr_tile(PIN(17) + (size_t)l * 512 * 1024, 1024, kt * 64, nt * 64, 0, (bf16_t*)(ws + WS_WBR), 512, 0, tile);
        } else if (it < T2) { const int j = it - T1, nt = j / 4, kt = j % 4;
            tr_tile(PIN(18) + (size_t)l * 256 * 1024, 1024, kt * 64, nt * 64, 0, (bf16_t*)(ws + WS_WBR) + 1024 * 512, 512, 0, tile);
        } else if (it < T2b) { const int j = it - T2, nt = j / 4, kt = j % 4;
            tr_tile(PIN(18), 1024, kt * 64, nt * 64, 3, (bf16_t*)(ws + WS_WBR) + 1024 * 512, 512, 256, tile);
        } else if (it < T2c) { const int j = it - T2b, nt = j / 4, kt = j % 4;
            tr_tile(PIN(19), 1024, kt * 64, nt * 64, 3, (bf16_t*)(ws + WS_WBR) + 2048 * 512, 512, 0, tile);
        } else if (it < T3) { const int j = it - T2c, nt = j / 4, kt = j % 4;
            tr_tile(PIN(19) + (size_t)l * 256 * 1024, 1024, kt * 64, nt * 64, 0, (bf16_t*)(ws + WS_WBR) + 2048 * 512, 512, 256, tile);
        } else if (it < T4) { const int j = it - T3, nt = j / 16, kt = j % 16;
            tr_tile(PIN(20) + (size_t)l * 1024 * 1024, 1024, kt * 64, nt * 64, 0, (bf16_t*)(ws + WS_WO), 1024, 0, tile);
        } else if (it < T5) { const int j = it - T4, nt = j / 16, kt = j % 16;
            tr_tile(PIN(21) + (size_t)l * 1024 * UPN, UPN, kt * 64, nt * 64, 2, (bf16_t*)(ws + WS_WUP), 1024, 0, tile);
        } else { const int j = it - T5, nt = j / 44, kt = j % 44;
            tr_tile(PIN(24) + (size_t)l * DFF * 1024, 1024, kt * 64, nt * 64, 0, (bf16_t*)(ws + WS_WDN), DFF, 0, tile);
        }
    }
}

DI void phase_rowpass(unsigned char* ws, int nrows, const float* xin_lat, const float* xin_ctx, const float* y, const float* gate_base  ,
                      const float* gpost, bool write_x, bool write_h, const float* hmod_base  , int sc_which, int sh_which, const float* gpre) {
    const int lane = otid() & 63, wave = otid() >> 6;
    float eps = EPS; asm volatile("" : "+v"(eps));
    float* xout_lat = (float*)PIN(25); float* xout_ctx = (float*)(ws + WS_CTXRES);
    bf16_t* H = (bf16_t*)(ws + WS_H);
    const int nwv = ogrid() * 8, per = (nrows + nwv - 1) / nwv;
    int r = (obid() * 8 + wave) * per;
    const int rend = min(r + per, nrows);
    f32x4 xv[4], yv[4], xnx[4], ynx[4];
    f32x4 vgt[4], vgp[4], vpre[4], vsc[4], vsh[4];
#pragma unroll
    for (int i = 0; i < 4; ++i) { xv[i] = (f32x4){0.f, 0.f, 0.f, 0.f}; yv[i] = xv[i]; xnx[i] = xv[i]; ynx[i] = xv[i]; vgt[i] = xv[i]; vgp[i] = xv[i]; vpre[i] = xv[i]; vsc[i] = xv[i]; vsh[i] = xv[i]; }
    if (r < rend) {
        const float* xi = r < ML ? xin_lat + (size_t)r * 1024 : xin_ctx + (size_t)(r - ML) * 1024;
#pragma unroll
        for (int i = 0; i < 4; ++i) xv[i] = __builtin_nontemporal_load((const f32x4*)(xi + i * 256 + lane * 4));
        if (y) {
#pragma unroll
            for (int i = 0; i < 4; ++i) yv[i] = __builtin_nontemporal_load((const f32x4*)(y + (size_t)r * 1024 + i * 256 + lane * 4));
        }
#pragma unroll
        for (int i = 0; i < 4; ++i) { if (y) vgp[i] = *(const f32x4*)(gpost + i * 256 + lane * 4); if (write_h) vpre[i] = *(const f32x4*)(gpre + i * 256 + lane * 4); }
    }
    int mi_cur = -1;
#pragma unroll 1
    for (; r < rend; ++r) {
        const int mi = r < ML ? (r >> 12) : 8;
        const int rn = r + 1;
        if (rn < rend) {
            const float* xi = rn < ML ? xin_lat + (size_t)rn * 1024 : xin_ctx + (size_t)(rn - ML) * 1024;
#pragma unroll
            for (int i = 0; i < 4; ++i) xnx[i] = __builtin_nontemporal_load((const f32x4*)(xi + i * 256 + lane * 4));
            if (y) {
#pragma unroll
                for (int i = 0; i < 4; ++i) ynx[i] = __builtin_nontemporal_load((const f32x4*)(y + (size_t)rn * 1024 + i * 256 + lane * 4));
            }
        }
        if (mi != mi_cur) {
            mi_cur = mi;
#pragma unroll
            for (int i = 0; i < 4; ++i) {
                if (y) vgt[i] = *(const f32x4*)(gate_base + (size_t)mi * 6144 + i * 256 + lane * 4);
                if (write_h) { vsc[i] = *(const f32x4*)(hmod_base + ((size_t)mi * 6 + sc_which) * 1024 + i * 256 + lane * 4);
                               vsh[i] = *(const f32x4*)(hmod_base + ((size_t)mi * 6 + sh_which) * 1024 + i * 256 + lane * 4); }
            }
        }
        if (y) {
            float ss = 0.f;
#pragma unroll
            for (int i = 0; i < 4; ++i) ss += yv[i][0] * yv[i][0] + yv[i][1] * yv[i][1] + yv[i][2] * yv[i][2] + yv[i][3] * yv[i][3];
            ss = wave_sum(ss);
            const float rs = rsqrtf(ss * (1.f / 1024.f) + eps);
#pragma unroll
            for (int i = 0; i < 4; ++i)
#pragma unroll
                for (int j = 0; j < 4; ++j) xv[i][j] += vgt[i][j] * (yv[i][j] * rs * vgp[i][j]);
        }
        if (write_x) {
            float* xo = r < ML ? xout_lat + (size_t)r * 1024 : xout_ctx + (size_t)(r - ML) * 1024;
#pragma unroll
            for (int i = 0; i < 4; ++i) __builtin_nontemporal_store(xv[i], (f32x4*)(xo + i * 256 + lane * 4));
        }
        if (write_h) {
            float ss = 0.f;
#pragma unroll
            for (int i = 0; i < 4; ++i) ss += xv[i][0] * xv[i][0] + xv[i][1] * xv[i][1] + xv[i][2] * xv[i][2] + xv[i][3] * xv[i][3];
            ss = wave_sum(ss);
            const float rs = rsqrtf(ss * (1.f / 1024.f) + eps);
#pragma unroll
            for (int i = 0; i < 4; ++i) {
                float hv[4];
#pragma unroll
                for (int j = 0; j < 4; ++j) hv[j] = (xv[i][j] * rs * vpre[i][j]) * (1.f + vsc[i][j]) + vsh[i][j];
                u32x2 o; o[0] = pk_bf16(hv[0], hv[1]); o[1] = pk_bf16(hv[2], hv[3]);
                *(u32x2*)(H + (size_t)r * 1024 + i * 256 + lane * 4) = o;
            }
        }
#pragma unroll
        for (int i = 0; i < 4; ++i) { xv[i] = xnx[i]; yv[i] = ynx[i]; }
    }
}

DI void attn_item(const bf16_t* P, bf16_t* Y, const float* sinkp, const float* rope, unsigned char* lds, bool is_ctx, int b, int blk, int hp) {
    bf16_t* Ks = (bf16_t*)lds;
    const int tid = otid(), wave = tid >> 6, lane = tid & 63, fr = lane & 15, fq = lane >> 4;
    const int kvh = hp >> 1, h = hp * 2 + (wave >> 2);
    const size_t qrow0 = is_ctx ? (size_t)ML + b * 256 + blk * 128 : (size_t)b * 4096 + blk * 128;
    const int qi0 = (wave & 3) * 32 + fr;
    const int sp0 = is_ctx ? 2 : (blk == 0 ? 1 : 0), sp1 = is_ctx ? 4 : (blk == 31 ? 4 : 5);
    u32x4 rk0, rk1, rv0, rv1; f32x4 rrt[4];
    const int skey = tid >> 2, sdq = tid & 3;
#define ATT_LOAD(sp_) do { const int ch_ = (sp_) < 2 ? (sp_) : ((sp_) < 4 ? (sp_) + 1 : 2); size_t kr_; \
        if (ch_ < 3) { const int kb_ = is_ctx ? 0 : blk - 1 + ch_; kr_ = (size_t)b * 4096 + kb_ * 128; \
            const int tk_ = kb_ * 128 + skey; const int pos_ = sdq < 2 ? (tk_ >> 6) : (tk_ & 63); const float* rt_ = rope + (pos_ * 16 + (sdq & 1) * 8) * 2; \
            _Pragma("unroll") for (int j_ = 0; j_ < 4; ++j_) rrt[j_] = *(const f32x4*)(rt_ + 4 * j_); } \
        else kr_ = (size_t)ML + b * 256 + (ch_ - 3) * 128; \
        const bf16_t* kp_ = P + (kr_ + skey) * IN_DIM + C_AK + kvh * 64 + sdq * 8; rk0 = *(const u32x4*)kp_; rk1 = *(const u32x4*)(kp_ + 32); \
        const bf16_t* vp_ = P + (kr_ + skey) * IN_DIM + C_AV + kvh * 64 + sdq * 8; rv0 = *(const u32x4*)vp_; rv1 = *(const u32x4*)(vp_ + 32); } while (0)
    ATT_LOAD(sp0);
    bf16x8 Qf0[2], Qf1[2];
#pragma unroll
    for (int t = 0; t < 2; ++t) {
        const int qi = qi0 + 16 * t, tq = blk * 128 + qi;
        const bf16_t* qp = P + (qrow0 + qi) * IN_DIM + C_AQ + h * 64 + fq * 8;
        const u32x4 q0 = *(const u32x4*)qp, q1 = *(const u32x4*)(qp + 32);
        float qa[8], qb[8];
#pragma unroll
        for (int j = 0; j < 4; ++j) { qa[2 * j] = lo_f(q0[j]); qa[2 * j + 1] = hi_f(q0[j]); qb[2 * j] = lo_f(q1[j]); qb[2 * j + 1] = hi_f(q1[j]); }
        if (!is_ctx) {
            const int pos = fq < 2 ? (tq >> 6) : (tq & 63);
            const float* rt = rope + (pos * 16 + (fq & 1) * 8) * 2;
#pragma unroll
            for (int j = 0; j < 8; ++j) { const float c = rt[2 * j], s = rt[2 * j + 1]; const float a = qa[j], bb = qb[j]; qa[j] = a * c - bb * s; qb[j] = a * s + bb * c; }
        }
        const float qs = 0.125f * 1.4426950408889634f;
        u32x4 o0, o1;
#pragma unroll
        for (int j = 0; j < 4; ++j) { o0[j] = pk_bf16_mfma(qa[2 * j] * qs, qa[2 * j + 1] * qs); o1[j] = pk_bf16_mfma(qb[2 * j] * qs, qb[2 * j + 1] * qs); }
        Qf0[t] = __builtin_bit_cast(bf16x8, o0); Qf1[t] = __builtin_bit_cast(bf16x8, o1);
    }
    float m_run[2], l_run[2];
    f32x4 O[2][4];
    {   const float sk = sinkp[h] * 1.4426950408889634f;
#pragma unroll
        for (int t = 0; t < 2; ++t) { m_run[t] = sk; l_run[t] = 1.f;
#pragma unroll
            for (int dt = 0; dt < 4; ++dt) O[t][dt] = (f32x4){0.f, 0.f, 0.f, 0.f}; } }
    __syncthreads();
#pragma unroll 1
    for (int sp = sp0; sp < sp1; ++sp) {
        const int ch = sp < 2 ? sp : (sp < 4 ? sp + 1 : 2);
        const int mask = (ch < 3 && !is_ctx) ? ch : 1;
        const int bufsel = (sp - sp0) & 1;
        bf16_t* Kb = Ks + bufsel * (128 * 72 + 128 * 80);
        bf16_t* Vb = Kb + 128 * 72;
        {
            u32x4 k0 = rk0, k1 = rk1;
            if (ch < 3) {
                float ka[8], kb2[8];
#pragma unroll
                for (int j = 0; j < 4; ++j) { ka[2 * j] = lo_f(k0[j]); ka[2 * j + 1] = hi_f(k0[j]); kb2[2 * j] = lo_f(k1[j]); kb2[2 * j + 1] = hi_f(k1[j]); }
#pragma unroll
                for (int j = 0; j < 8; ++j) { const float c = rrt[j >> 1][(j & 1) * 2], s = rrt[j >> 1][(j & 1) * 2 + 1]; const float a = ka[j], bb = kb2[j]; ka[j] = a * c - bb * s; kb2[j] = a * s + bb * c; }
#pragma unroll
                for (int j = 0; j < 4; ++j) { k0[j] = pk_bf16(ka[2 * j], ka[2 * j + 1]); k1[j] = pk_bf16(kb2[2 * j], kb2[2 * j + 1]); }
            }
            *(u32x4*)(Kb + skey * 72 + sdq * 8) = k0;
            *(u32x4*)(Kb + skey * 72 + 32 + sdq * 8) = k1;
            *(u32x4*)(Vb + skey * 80 + sdq * 8) = rv0;
            *(u32x4*)(Vb + skey * 80 + 32 + sdq * 8) = rv1;
        }
        if (sp + 1 < sp1) ATT_LOAD(sp + 1);
        __syncthreads();
        f32x4 S[2][8];
#pragma unroll
        for (int kt = 0; kt < 8; ++kt) {
            const bf16x8 a0 = *(const bf16x8*)(Kb + (kt * 16 + fr) * 72 + fq * 8);
            const bf16x8 a1 = *(const bf16x8*)(Kb + (kt * 16 + fr) * 72 + 32 + fq * 8);
#pragma unroll
            for (int t = 0; t < 2; ++t) {
                f32x4 z = (f32x4){0.f, 0.f, 0.f, 0.f};
                z = __builtin_amdgcn_mfma_f32_16x16x32_bf16(a0, Qf0[t], z, 0, 0, 0);
                S[t][kt] = __builtin_amdgcn_mfma_f32_16x16x32_bf16(a1, Qf1[t], z, 0, 0, 0);
            }
        }
#pragma unroll
        for (int t = 0; t < 2; ++t) {
            if (mask != 1) {
                int dq = qi0 + 16 * t - fq * 4; float negbig = -1e30f; asm volatile("" : "+v"(dq), "+v"(negbig));
                if (mask == 2) dq = -dq;
#pragma unroll
                for (int kt = 0; kt < 8; ++kt)
#pragma unroll
                    for (int j = 0; j < 4; ++j) { const int kk = kt * 16 + j; const bool ok = (mask == 0) ? (kk >= dq) : (-kk >= dq); if (!ok) S[t][kt][j] = negbig; }
            }
            float mx = -1e30f;
#pragma unroll
            for (int kt = 0; kt < 8; ++kt)
#pragma unroll
                for (int j = 0; j < 4; ++j) mx = fmaxf(mx, S[t][kt][j]);
            mx = fmaxf(mx, shx(mx, 16, lane)); mx = fmaxf(mx, shx(mx, 32, lane));
            const float m_new = fmaxf(m_run[t], mx);
            const float alpha = __builtin_amdgcn_exp2f(m_run[t] - m_new);
            float sum = 0.f;
#pragma unroll
            for (int kt = 0; kt < 8; ++kt)
#pragma unroll
                for (int j = 0; j < 4; ++j) { const float e = __builtin_amdgcn_exp2f(S[t][kt][j] - m_new); S[t][kt][j] = e; sum += e; }
            sum += shx(sum, 16, lane); sum += shx(sum, 32, lane);
            l_run[t] = l_run[t] * alpha + sum; m_run[t] = m_new;
#pragma unroll
            for (int dt = 0; dt < 4; ++dt)
#pragma unroll
                for (int j = 0; j < 4; ++j) O[t][dt][j] *= alpha;
        }
#pragma unroll
        for (int i = 0; i < 4; ++i) {
            bf16x8 Pf[2];
#pragma unroll
            for (int t = 0; t < 2; ++t) {
                u32x4 pw; pw[0] = pk_bf16_mfma(S[t][2 * i][0], S[t][2 * i][1]); pw[1] = pk_bf16_mfma(S[t][2 * i][2], S[t][2 * i][3]); pw[2] = pk_bf16_mfma(S[t][2 * i + 1][0], S[t][2 * i + 1][1]); pw[3] = pk_bf16_mfma(S[t][2 * i + 1][2], S[t][2 * i + 1][3]);
                Pf[t] = __builtin_bit_cast(bf16x8, pw);
            }
#pragma unroll
            for (int dt = 0; dt < 4; ++dt) {
                const s16x4 lo = __builtin_amdgcn_ds_read_tr16_b64_v4i16((LAS s16x4*)(Vb + (32 * i + fq * 4 + (fr >> 2)) * 80 + dt * 16 + 4 * (fr & 3)));
                const s16x4 hi = __builtin_amdgcn_ds_read_tr16_b64_v4i16((LAS s16x4*)(Vb + (32 * i + 16 + fq * 4 + (fr >> 2)) * 80 + dt * 16 + 4 * (fr & 3)));
                const bf16x8 Vf = __builtin_shufflevector(lo, hi, 0, 1, 2, 3, 4, 5, 6, 7);
#pragma unroll
                for (int t = 0; t < 2; ++t) O[t][dt] = __builtin_amdgcn_mfma_f32_16x16x32_bf16(Vf, Pf[t], O[t][dt], 0, 0, 0);
            }
        }
    }
#undef ATT_LOAD
#pragma unroll
    for (int t = 0; t < 2; ++t) {
        const float inv = 1.f / l_run[t];
        bf16_t* yp = Y + (qrow0 + qi0 + 16 * t) * 1024 + h * 64 + fq * 4;
#pragma unroll
        for (int dt = 0; dt < 4; ++dt) { u32x2 o; o[0] = pk_bf16(O[t][dt][0] * inv, O[t][dt][1] * inv); o[1] = pk_bf16(O[t][dt][2] * inv, O[t][dt][3] * inv); *(u32x2*)(yp + dt * 16) = o; }
    }
    __syncthreads();
}

template <int W> DI void pool_window(const bf16_t* us, bf16_t* dd, int tid, int chn, int t0, int T) {
    constexpr int lo = W / 2, hi = W - lo - 1;
#pragma unroll 2
    for (int i = 0; i < 32; ++i) {
        const int tt = (tid >> 8) + 2 * i, t = t0 + tt;
        float s = 0.f;
#pragma unroll
        for (int k = -lo; k <= hi; ++k) s += bf2f(us[(tt + 8 + k) * 256 + chn]);
        const int cnt = min(t + hi + 1, T) - max(t - lo, 0);
        dd[tt * 264 + chn] = f2bf(s / (float)cnt - bf2f(us[(tt + 8) * 256 + chn]));
    }
}

DI void pool_item(const bf16_t* P, bf16_t* Y, const float* pool_w, const float* pool_scale, unsigned char* lds, int cid) {
    bf16_t* us = (bf16_t*)lds;
    bf16_t* dd = (bf16_t*)(lds + 79 * 256 * 2 + 64);
    bf16_t* Wt = dd + 64 * 264;
    const int tid = otid();
    const int row0 = cid * 64;
    int seq0, T;
    if (cid < 512) { seq0 = (cid >> 6) * 4096; T = 4096; } else { seq0 = ML + ((cid - 512) >> 2) * 256; T = 256; }
    const int t0 = row0 - seq0;
    __syncthreads();
#pragma unroll
    for (int i = 0; i < 5; ++i) {
        const int c = tid + i * NTHR;
        if (c < 79 * 32) {
            const int rr = c >> 5, cc = (c & 31) * 8; const int t = t0 - 8 + rr;
            u32x4 v = (u32x4){0u, 0u, 0u, 0u};
            if (t >= 0 && t < T) v = *(const u32x4*)(P + (size_t)(seq0 + t) * IN_DIM + C_PU + cc);
            *(u32x4*)(us + rr * 256 + cc) = v;
        }
    }
#pragma unroll
    for (int i = 0; i < 8; ++i) {
        const int c = tid + i * NTHR; const int gi = c >> 4, o4 = (c & 15) * 4;
        const f32x4 wv = *(const f32x4*)(pool_w + (size_t)gi * 64 + o4);
        u32x2 wo; wo[0] = pk_bf16(wv[0], wv[1]); wo[1] = pk_bf16(wv[2], wv[3]);
        *(u32x2*)(Wt + gi * 72 + o4) = wo;
    }
    __syncthreads();
    {
        const int chn = tid & 255, g = chn >> 6;
        if (g == 0) pool_window<2>(us, dd, tid, chn, t0, T);
        else if (g == 1) pool_window<4>(us, dd, tid, chn, t0, T);
        else if (g == 2) pool_window<8>(us, dd, tid, chn, t0, T);
        else pool_window<16>(us, dd, tid, chn, t0, T);
    }
    __syncthreads();
    {
        const int lane = tid & 63, fr = lane & 15, fq = lane >> 4, w = tid >> 6, g = w >> 1, th = w & 1;
#pragma unroll
        for (int mt = 0; mt < 2; ++mt)
#pragma unroll
            for (int nt = 0; nt < 4; ++nt) {
                f32x4 acc = (f32x4){0.f, 0.f, 0.f, 0.f};
#pragma unroll
                for (int ks = 0; ks < 2; ++ks) {
                    const bf16x8 a = *(const bf16x8*)(dd + (th * 32 + mt * 16 + fr) * 264 + g * 64 + ks * 32 + fq * 8);
                    const int wr_ = g * 64 + ks * 32 + fq * 8 + (fr >> 2), wc_ = nt * 16 + 4 * (fr & 3);
                    const s16x4 b0 = __builtin_amdgcn_ds_read_tr16_b64_v4i16((LAS s16x4*)(Wt + wr_ * 72 + wc_)), b1 = __builtin_amdgcn_ds_read_tr16_b64_v4i16((LAS s16x4*)(Wt + (wr_ + 4) * 72 + wc_));
                    const bf16x8 b = __builtin_shufflevector(b0, b1, 0, 1, 2, 3, 4, 5, 6, 7);
                    acc = __builtin_amdgcn_mfma_f32_16x16x32_bf16(b, a, acc, 0, 0, 0);
                }
                const f32x4 ps = *(const f32x4*)(pool_scale + g * 64 + nt * 16 + fq * 4);
                u32x2 o; o[0] = pk_bf16(acc[0] * ps[0], acc[1] * ps[1]); o[1] = pk_bf16(acc[2] * ps[2], acc[3] * ps[3]);
                *(u32x2*)(Y + (size_t)(row0 + th * 32 + mt * 16 + fr) * 1024 + 512 + g * 64 + nt * 16 + fq * 4) = o;
            }
    }
}

constexpr int GL_Q = 0, GL_K = GL_Q + 64 * 33, GL_V = GL_K + 64 * 33, GL_G = GL_V + 64 * 68, GL_BF = GL_G + 64 * 33, GL_BB = GL_BF + 64 * 33,
              GL_QT = GL_BB + 64 * 33, GL_KT = GL_QT + 64 * 33, GL_ATT = GL_KT + 64 * 33, GL_S = GL_ATT + 64 * 68, GL_END = GL_S + 32 * 68;
static_assert(GL_END * 4 <= 131072, "gla lds");
constexpr int G3_B0 = GL_QT * 4;
constexpr int G3_QT = G3_B0, G3_KT = G3_QT + 2 * 64 * 40 * 2, G3_ATT = G3_KT + 2 * 64 * 40 * 2, G3_VT = G3_ATT + 2 * 64 * 72 * 2,
              G3_ST = G3_VT + 64 * 72 * 2, G3_END = G3_ST + 2 * 32 * 72 * 2;
static_assert(G3_END <= 131072, "gla3 lds");

DI void gla_load(const bf16_t* P, const float* wa2  , const float* ba  , float* L, int cid, int hh) {
    const int tid = otid();
    const size_t row0 = (size_t)cid * 64;
    __syncthreads();
    {
        const int r = tid >> 3, d0 = (tid & 7) * 4;
        const bf16_t* rp = P + (row0 + r) * IN_DIM;
        const u32x2 kv = *(const u32x2*)(rp + C_GK + hh * 32 + d0), gv = *(const u32x2*)(rp + C_GLR + d0);
        L[GL_K + r * 33 + d0] = lo_f(kv[0]); L[GL_K + r * 33 + d0 + 1] = hi_f(kv[0]); L[GL_K + r * 33 + d0 + 2] = lo_f(kv[1]); L[GL_K + r * 33 + d0 + 3] = hi_f(kv[1]);
        L[GL_G + r * 33 + d0] = lo_f(gv[0]); L[GL_G + r * 33 + d0 + 1] = hi_f(gv[0]); L[GL_G + r * 33 + d0 + 2] = lo_f(gv[1]); L[GL_G + r * 33 + d0 + 3] = hi_f(gv[1]);
        const int e0 = (tid & 7) * 8;
        const u32x4 vv = *(const u32x4*)(rp + C_GV + hh * 64 + e0);
        {
            const int idx = tid * 2, wd = idx >> 9, wr_ = (idx >> 5) & 15, wdd = idx & 31;
            const f32x2 wv2 = *(const f32x2*)(wa2 + (wd * 16 + wr_) * 128 + hh * 32 + wdd);
            *(f32x2*)(L + GL_S + idx) = wv2;
            if (tid < 64) L[GL_S + 1024 + tid] = ba[(tid >> 5) * 128 + hh * 32 + (tid & 31)];
        }
        *(u32x4*)((bf16_t*)((unsigned char*)L + G3_VT) + r * 72 + e0) = vv;
    }
    __syncthreads();
    {
        const int r = tid >> 3, d0 = (tid & 7) * 4;
#pragma unroll
        for (int dir = 0; dir < 2; ++dir) {
            f32x4 z = *(const f32x4*)(L + GL_S + 1024 + dir * 32 + d0);
#pragma unroll
            for (int rr = 0; rr < 16; ++rr) {
                const float gl = L[GL_G + r * 33 + dir * 16 + rr];
                const f32x4 w = *(const f32x4*)(L + GL_S + (dir * 16 + rr) * 32 + d0);
                z[0] += gl * w[0]; z[1] += gl * w[1]; z[2] += gl * w[2]; z[3] += gl * w[3];
            }
#pragma unroll
            for (int j = 0; j < 4; ++j) {
                const float zz = z[j];
                const float ls = fminf(zz, 0.f) - __logf(1.f + __expf(-fabsf(zz)));
                L[(dir ? GL_BB : GL_BF) + r * 33 + d0 + j] = ls * (1.f / 16.f);
            }
        }
    }
    __syncthreads();
    {
        const int lane = tid & 63, wv = tid >> 6;
#pragma unroll
        for (int c = 0; c < 4; ++c) {
            const int d = wv * 4 + c;
            float vf = L[GL_BF + lane * 33 + d], vb = L[GL_BB + lane * 33 + d];
#pragma unroll
            for (int off = 1; off < 64; off <<= 1) {
                const float tf = __int_as_float(__builtin_amdgcn_ds_bpermute(((lane - off) & 63) << 2, __float_as_int(vf)));
                const float tb = __int_as_float(__builtin_amdgcn_ds_bpermute(((lane + off) & 63) << 2, __float_as_int(vb)));
                vf += (lane >= off) ? tf : 0.f;
                vb += (lane + off < 64) ? tb : 0.f;
            }
            L[GL_BF + lane * 33 + d] = vf; L[GL_BB + lane * 33 + d] = vb;
        }
    }
    __syncthreads();
}

DI void gla_load3(const bf16_t* P, const float* GBi, float* L, int cid, int hh) {
    const int tid = otid();
    const size_t row0 = (size_t)cid * 64;
    __syncthreads();
    {
        const int r = tid >> 3, d0 = (tid & 7) * 4;
        const bf16_t* rp = P + (row0 + r) * IN_DIM;
        const u32x2 qv = *(const u32x2*)(rp + C_GQ + hh * 32 + d0), kv = *(const u32x2*)(rp + C_GK + hh * 32 + d0);
        const f32x4 bfv = *(const f32x4*)(GBi + r * 32 + d0), bbv = *(const f32x4*)(GBi + 2048 + r * 32 + d0);
        const int e0 = (tid & 7) * 8;
        const u32x4 vv = *(const u32x4*)(rp + C_GV + hh * 64 + e0);
        const float qs = 0.17677669529663687f;
        L[GL_Q + r * 33 + d0] = lo_f(qv[0]) * qs; L[GL_Q + r * 33 + d0 + 1] = hi_f(qv[0]) * qs; L[GL_Q + r * 33 + d0 + 2] = lo_f(qv[1]) * qs; L[GL_Q + r * 33 + d0 + 3] = hi_f(qv[1]) * qs;
        L[GL_K + r * 33 + d0] = lo_f(kv[0]); L[GL_K + r * 33 + d0 + 1] = hi_f(kv[0]); L[GL_K + r * 33 + d0 + 2] = lo_f(kv[1]); L[GL_K + r * 33 + d0 + 3] = hi_f(kv[1]);
#pragma unroll
        for (int j = 0; j < 4; ++j) { L[GL_BF + r * 33 + d0 + j] = bfv[j]; L[GL_BB + r * 33 + d0 + j] = bbv[j]; }
        *(f32x4*)(L + GL_V + r * 68 + e0) = (f32x4){lo_f(vv[0]), hi_f(vv[0]), lo_f(vv[1]), hi_f(vv[1])};
        *(f32x4*)(L + GL_V + r * 68 + e0 + 4) = (f32x4){lo_f(vv[2]), hi_f(vv[2]), lo_f(vv[3]), hi_f(vv[3])};
    }
    __syncthreads();
}

DI void gla_pass1_item(unsigned char* ws, const float* wa2, const float* gba, unsigned char* lds, int cid, int hh) {
    float* L = (float*)lds;
    const bf16_t* P = (const bf16_t*)(ws + WS_P);
    gla_load(P, wa2, gba, L, cid, hh);
    const int tid = otid();
    float* GKV = (float*)(ws + WS_M2); float* GDEC = (float*)(ws + WS_GDEC);
    {
        float* GB = (float*)(ws + WS_M2) + (size_t)NCH * 4 * 2 * 2048 + ((size_t)cid * 4 + hh) * 4096;
        const int r = tid >> 3, d0 = (tid & 7) * 4;
        *(f32x4*)(GB + r * 32 + d0) = (f32x4){L[GL_BF + r * 33 + d0], L[GL_BF + r * 33 + d0 + 1], L[GL_BF + r * 33 + d0 + 2], L[GL_BF + r * 33 + d0 + 3]};
        *(f32x4*)(GB + 2048 + r * 32 + d0) = (f32x4){L[GL_BB + r * 33 + d0], L[GL_BB + r * 33 + d0 + 1], L[GL_BB + r * 33 + d0 + 2], L[GL_BB + r * 33 + d0 + 3]};
    }
    bf16_t* KD = (bf16_t*)(lds + G3_QT);
    bf16_t* VB = (bf16_t*)(lds + G3_VT);
    {
        const int c = tid >> 3, d0 = (tid & 7) * 4;
        float kf[4], kb[4];
#pragma unroll
        for (int j = 0; j < 4; ++j) {
            const float k = L[GL_K + c * 33 + d0 + j];
            kf[j] = k * __expf(L[GL_BF + 63 * 33 + d0 + j] - L[GL_BF + c * 33 + d0 + j]);
            kb[j] = k * __expf(L[GL_BB + 0 * 33 + d0 + j] - L[GL_BB + c * 33 + d0 + j]);
        }
        u32x2 o;
        o[0] = pk_bf16(kf[0], kf[1]); o[1] = pk_bf16(kf[2], kf[3]); *(u32x2*)(KD + c * 40 + d0) = o;
        o[0] = pk_bf16(kb[0], kb[1]); o[1] = pk_bf16(kb[2], kb[3]); *(u32x2*)(KD + 64 * 40 + c * 40 + d0) = o;
    }
    __syncthreads();
    const size_t idx = ((size_t)cid * 4 + hh) * 2;
    {
        const int lane = tid & 63, fr = lane & 15, fq = lane >> 4, wv = tid >> 6, dir = wv >> 2, et = wv & 3;
        const bf16_t* KDd = KD + dir * 64 * 40;
        f32x4 a0 = (f32x4){0.f, 0.f, 0.f, 0.f}, a1 = a0;
#pragma unroll
        for (int ks = 0; ks < 2; ++ks) {
            const int trr = ks * 32 + fq * 8 + (fr >> 2), trc = 4 * (fr & 3);
            const s16x4 v0 = __builtin_amdgcn_ds_read_tr16_b64_v4i16((LAS s16x4*)(VB + trr * 72 + et * 16 + trc)), v1 = __builtin_amdgcn_ds_read_tr16_b64_v4i16((LAS s16x4*)(VB + (trr + 4) * 72 + et * 16 + trc));
            const s16x4 k00 = __builtin_amdgcn_ds_read_tr16_b64_v4i16((LAS s16x4*)(KDd + trr * 40 + trc)), k01 = __builtin_amdgcn_ds_read_tr16_b64_v4i16((LAS s16x4*)(KDd + (trr + 4) * 40 + trc));
            const s16x4 k10 = __builtin_amdgcn_ds_read_tr16_b64_v4i16((LAS s16x4*)(KDd + trr * 40 + 16 + trc)), k11 = __builtin_amdgcn_ds_read_tr16_b64_v4i16((LAS s16x4*)(KDd + (trr + 4) * 40 + 16 + trc));
            const bf16x8 vf = __builtin_shufflevector(v0, v1, 0, 1, 2, 3, 4, 5, 6, 7);
            const bf16x8 kf0 = __builtin_shufflevector(k00, k01, 0, 1, 2, 3, 4, 5, 6, 7), kf1 = __builtin_shufflevector(k10, k11, 0, 1, 2, 3, 4, 5, 6, 7);
            a0 = __builtin_amdgcn_mfma_f32_16x16x32_bf16(vf, kf0, a0, 0, 0, 0);
            a1 = __builtin_amdgcn_mfma_f32_16x16x32_bf16(vf, kf1, a1, 0, 0, 0);
        }
        float* gk = GKV + (idx + dir) * 2048 + et * 16 + fq * 4;
        *(f32x4*)(gk + (size_t)fr * 64) = a0;
        *(f32x4*)(gk + (size_t)(16 + fr) * 64) = a1;
    }
    if (tid < 32) GDEC[idx * 32 + tid] = __expf(L[GL_BF + 63 * 33 + tid]);
    else if (tid < 64) GDEC[(idx + 1) * 32 + (tid - 32)] = __expf(L[GL_BB + 0 * 33 + (tid - 32)]);
}

DI void phase_gla_scan(unsigned char* ws) {
    float* GKV = (float*)(ws + WS_M2); const float* GDEC = (const float*)(ws + WS_GDEC);
    const int tid = otid();
    for (int vb = obid(); vb < 256; vb += ogrid()) {
        const int sid = vb >> 2, quarter = vb & 3; const int b = sid >> 3, hh = (sid >> 1) & 3, dir = sid & 1;
        const int elem = quarter * 512 + tid, d = elem >> 6;
        float S = 0.f;
        for (int s0 = 0; s0 < 68; s0 += 17) {
            float kv[17], dc[17]; unsigned ix[17];
#pragma unroll
            for (int u = 0; u < 17; ++u) {
                const int s = s0 + u;
                int cid;
                if (dir == 0) cid = s < 4 ? 512 + b * 4 + s : b * 64 + (s - 4);
                else cid = s < 4 ? 512 + b * 4 + (3 - s) : b * 64 + (63 - (s - 4));
                ix[u] = (unsigned)((cid * 4 + hh) * 2 + dir);
                kv[u] = GKV[(size_t)ix[u] * 2048 + elem]; dc[u] = GDEC[ix[u] * 32 + d];
            }
#pragma unroll
            for (int u = 0; u < 17; ++u) { GKV[(size_t)ix[u] * 2048 + elem] = S; S = S * dc[u] + kv[u]; }
        }
    }
}

DI void gla_pass3_item(unsigned char* ws, const float* wa2, const float* gba, const float* gnorm, unsigned char* lds, int cid, int hh) {
    float* L = (float*)lds;
    const bf16_t* P = (const bf16_t*)(ws + WS_P);
    bf16_t* Y = (bf16_t*)(ws + WS_H);
    const int tid = otid(), lane = tid & 63, fr = lane & 15, fq = lane >> 4, wv = tid >> 6, dir = wv >> 2, mt = wv & 3;
    bf16_t* QT = (bf16_t*)(lds + G3_QT); bf16_t* KT = (bf16_t*)(lds + G3_KT); bf16_t* ATT = (bf16_t*)(lds + G3_ATT);
    bf16_t* VT = (bf16_t*)(lds + G3_VT); bf16_t* ST = (bf16_t*)(lds + G3_ST);
    float* OB = L + GL_Q;
    {
        const int c = tid >> 3, d0 = (tid & 7) * 4, e0 = (tid & 7) * 8;
        const bf16_t* rp = P + ((size_t)cid * 64 + c) * IN_DIM;
        const float* GBi = (const float*)(ws + WS_M2) + (size_t)NCH * 4 * 2 * 2048 + ((size_t)cid * 4 + hh) * 4096;
        const u32x2 qv = *(const u32x2*)(rp + C_GQ + hh * 32 + d0), kv = *(const u32x2*)(rp + C_GK + hh * 32 + d0);
        const f32x4 bfv = *(const f32x4*)(GBi + c * 32 + d0), bbv = *(const f32x4*)(GBi + 2048 + c * 32 + d0);
        const u32x4 vv = *(const u32x4*)(rp + C_GV + hh * 64 + e0);
        const int sd = tid >> 8, d = (tid & 255) >> 3;
        const float* GSp = (const float*)(ws + WS_M2) + (((size_t)cid * 4 + hh) * 2 + sd) * 2048 + d * 64 + e0;
        const f32x4 s0 = *(const f32x4*)GSp, s1 = *(const f32x4*)(GSp + 4);
        __syncthreads();
        const float qs = 0.17677669529663687f;
        const float qq[4] = {lo_f(qv[0]) * qs, hi_f(qv[0]) * qs, lo_f(qv[1]) * qs, hi_f(qv[1]) * qs};
        const float kk[4] = {lo_f(kv[0]), hi_f(kv[0]), lo_f(kv[1]), hi_f(kv[1])};
        float qf[4], kf[4], qb[4], kb[4];
#pragma unroll
        for (int j = 0; j < 4; ++j) { qf[j] = qq[j] * __expf(bfv[j]); kf[j] = kk[j] * __expf(-bfv[j]); qb[j] = qq[j] * __expf(bbv[j]); kb[j] = kk[j] * __expf(-bbv[j]); }
        u32x2 o;
        o[0] = pk_bf16(qf[0], qf[1]); o[1] = pk_bf16(qf[2], qf[3]); *(u32x2*)(QT + c * 40 + d0) = o;
        o[0] = pk_bf16(kf[0], kf[1]); o[1] = pk_bf16(kf[2], kf[3]); *(u32x2*)(KT + c * 40 + d0) = o;
        o[0] = pk_bf16(qb[0], qb[1]); o[1] = pk_bf16(qb[2], qb[3]); *(u32x2*)(QT + 64 * 40 + c * 40 + d0) = o;
        o[0] = pk_bf16(kb[0], kb[1]); o[1] = pk_bf16(kb[2], kb[3]); *(u32x2*)(KT + 64 * 40 + c * 40 + d0) = o;
        *(u32x4*)(VT + c * 72 + e0) = vv;
        {   u32x4 so; so[0] = pk_bf16(s0[0], s0[1]); so[1] = pk_bf16(s0[2], s0[3]); so[2] = pk_bf16(s1[0], s1[1]); so[3] = pk_bf16(s1[2], s1[3]);
            *(u32x4*)(ST + sd * 32 * 72 + d * 72 + e0) = so; }
    }
    __syncthreads();
    const bf16_t* QTd = QT + dir * 64 * 40; const bf16_t* KTd = KT + dir * 64 * 40; bf16_t* ATTd = ATT + dir * 64 * 72; const bf16_t* STd = ST + dir * 32 * 72;
    {
        const bf16x8 qfrag = *(const bf16x8*)(QTd + (mt * 16 + fr) * 40 + fq * 8);
        const int i = mt * 16 + fr;
#pragma unroll
        for (int nt = 0; nt < 4; ++nt) {
            const bf16x8 kfrag = *(const bf16x8*)(KTd + (nt * 16 + fr) * 40 + fq * 8);
            f32x4 a = (f32x4){0.f, 0.f, 0.f, 0.f};
            a = __builtin_amdgcn_mfma_f32_16x16x32_bf16(kfrag, qfrag, a, 0, 0, 0);
            float r[4];
#pragma unroll
            for (int jq = 0; jq < 4; ++jq) { const int j = nt * 16 + fq * 4 + jq; const int dji = dir ? (j - i) : (i - j); r[jq] = (dji >= 0) ? a[jq] : 0.f; }
            u32x2 o; o[0] = pk_bf16(r[0], r[1]); o[1] = pk_bf16(r[2], r[3]);
            *(u32x2*)(ATTd + (mt * 16 + fr) * 72 + nt * 16 + fq * 4) = o;
        }
    }
    __syncthreads();
    f32x4 o4[4];
    {
        const bf16x8 af0 = *(const bf16x8*)(ATTd + (mt * 16 + fr) * 72 + fq * 8), af1 = *(const bf16x8*)(ATTd + (mt * 16 + fr) * 72 + 32 + fq * 8);
        const bf16x8 qfrag = *(const bf16x8*)(QTd + (mt * 16 + fr) * 40 + fq * 8);
#pragma unroll
        for (int nt = 0; nt < 4; ++nt) {
            const int trc = nt * 16 + 4 * (fr & 3), trr = fq * 8 + (fr >> 2);
            const s16x4 v0a = __builtin_amdgcn_ds_read_tr16_b64_v4i16((LAS s16x4*)(VT + (trr) * 72 + trc)), v0b = __builtin_amdgcn_ds_read_tr16_b64_v4i16((LAS s16x4*)(VT + (trr + 4) * 72 + trc));
            const s16x4 v1a = __builtin_amdgcn_ds_read_tr16_b64_v4i16((LAS s16x4*)(VT + (32 + trr) * 72 + trc)), v1b = __builtin_amdgcn_ds_read_tr16_b64_v4i16((LAS s16x4*)(VT + (32 + trr + 4) * 72 + trc));
            const s16x4 sfa = __builtin_amdgcn_ds_read_tr16_b64_v4i16((LAS s16x4*)(STd + (trr) * 72 + trc)), sfb = __builtin_amdgcn_ds_read_tr16_b64_v4i16((LAS s16x4*)(STd + (trr + 4) * 72 + trc));
            const bf16x8 v0 = __builtin_shufflevector(v0a, v0b, 0, 1, 2, 3, 4, 5, 6, 7), v1 = __builtin_shufflevector(v1a, v1b, 0, 1, 2, 3, 4, 5, 6, 7), sf = __builtin_shufflevector(sfa, sfb, 0, 1, 2, 3, 4, 5, 6, 7);
            f32x4 a = (f32x4){0.f, 0.f, 0.f, 0.f};
            a = __builtin_amdgcn_mfma_f32_16x16x32_bf16(v0, af0, a, 0, 0, 0);
            a = __builtin_amdgcn_mfma_f32_16x16x32_bf16(v1, af1, a, 0, 0, 0);
            a = __builtin_amdgcn_mfma_f32_16x16x32_bf16(sf, qfrag, a, 0, 0, 0);
            o4[nt] = a;
        }
    }
    if (dir == 1) {
#pragma unroll
        for (int nt = 0; nt < 4; ++nt) {
            float* ob = OB + (mt * 16 + fr) * 66 + nt * 16 + fq * 4;
            *(f32x2*)ob = (f32x2){o4[nt][0], o4[nt][1]}; *(f32x2*)(ob + 2) = (f32x2){o4[nt][2], o4[nt][3]};
        }
    }
    __syncthreads();
    if (dir == 0) {
        float ss = 0.f;
#pragma unroll
        for (int nt = 0; nt < 4; ++nt) {
            const float* ob = OB + (mt * 16 + fr) * 66 + nt * 16 + fq * 4;
            const f32x2 b0 = *(const f32x2*)ob, b1 = *(const f32x2*)(ob + 2);
            o4[nt][0] += b0[0]; o4[nt][1] += b0[1]; o4[nt][2] += b1[0]; o4[nt][3] += b1[1];
            ss += o4[nt][0] * o4[nt][0] + o4[nt][1] * o4[nt][1] + o4[nt][2] * o4[nt][2] + o4[nt][3] * o4[nt][3];
        }
        ss += shx(ss, 16, lane); ss += shx(ss, 32, lane);
        float eps = EPS; asm volatile("" : "+v"(eps));
        const float rs = rsqrtf(ss * (1.f / 64.f) + eps);
        const size_t row = (size_t)cid * 64 + mt * 16 + fr;
#pragma unroll
        for (int nt = 0; nt < 4; ++nt) {
            const int e = nt * 16 + fq * 4;
            const f32x4 gn = *(const f32x4*)(gnorm + hh * 64 + e);
            const u32x2 rv = *(const u32x2*)(P + row * IN_DIM + C_GR + hh * 64 + e);
            const float r0 = lo_f(rv[0]), r1 = hi_f(rv[0]), r2 = lo_f(rv[1]), r3 = hi_f(rv[1]);
            u32x2 ov; ov[0] = pk_bf16(o4[nt][0] * rs * gn[0] * siluf_(r0), o4[nt][1] * rs * gn[1] * siluf_(r1)); ov[1] = pk_bf16(o4[nt][2] * rs * gn[2] * siluf_(r2), o4[nt][3] * rs * gn[3] * siluf_(r3));
            *(u32x2*)(Y + row * 1024 + 768 + hh * 64 + e) = ov;
        }
    }
}

DI void phase_conv_fixup(const float* EDGE, bf16_t* ACT, const float* cw, const float* cb) {
    const int ntask = 128 * 2 * 704;
    for (int task = obid() * NTHR + otid(); task < ntask; task += ogrid() * NTHR) {
        const int jg = task % 704, tw = task / 704, which = tw & 1, pm = tw >> 1;
        const int j0 = jg * 4, ucol = (j0 >> 7) * 256 + (j0 & 127);
        const float *pr, *cu, *nx; int row;
        if (which == 0) { if ((pm & 15) == 0) continue; pr = EDGE + ((size_t)(pm - 1) * 4 + 3) * UPN; cu = EDGE + ((size_t)pm * 4 + 0) * UPN; nx = EDGE + ((size_t)pm * 4 + 1) * UPN; row = pm * 256; }
        else { if ((pm & 15) == 15) continue; pr = EDGE + ((size_t)pm * 4 + 2) * UPN; cu = EDGE + ((size_t)pm * 4 + 3) * UPN; nx = EDGE + ((size_t)(pm + 1) * 4 + 0) * UPN; row = pm * 256 + 255; }
        const f32x4 pa = *(const f32x4*)(pr + ucol), pg = *(const f32x4*)(pr + ucol + 128), ca = *(const f32x4*)(cu + ucol), cg_ = *(const f32x4*)(cu + ucol + 128), na = *(const f32x4*)(nx + ucol), ng = *(const f32x4*)(nx + ucol + 128);
        const f32x4 w0a = *(const f32x4*)(cw + j0), w1a = *(const f32x4*)(cw + UPN + j0), w2a = *(const f32x4*)(cw + 2 * UPN + j0), bba = *(const f32x4*)(cb + j0);
        const f32x4 w0g = *(const f32x4*)(cw + DFF + j0), w1g = *(const f32x4*)(cw + UPN + DFF + j0), w2g = *(const f32x4*)(cw + 2 * UPN + DFF + j0), bbg = *(const f32x4*)(cb + DFF + j0);
        float r[4];
#pragma unroll
        for (int e = 0; e < 4; ++e) { const float av = w0a[e] * pa[e] + w1a[e] * ca[e] + w2a[e] * na[e] + bba[e]; const float gv = w0g[e] * pg[e] + w1g[e] * cg_[e] + w2g[e] * ng[e] + bbg[e]; r[e] = av * siluf_(gv); }
        u32x2 o; o[0] = pk_bf16(r[0], r[1]); o[1] = pk_bf16(r[2], r[3]);
        *(u32x2*)(ACT + (size_t)row * DFF + j0) = o;
    }
}

DI void phase_merge_sum(const bf16_t* P, bf16_t* M2, int nrows) {
    const int lane = otid() & 63, wave = otid() >> 6;
    for (int r = obid() * 8 + wave; r < nrows; r += ogrid() * 8) {
        const bf16_t* gp = P + (size_t)r * IN_DIM + C_MG + lane * 8;
        u32x4 v[3][2];
#pragma unroll
        for (int b = 0; b < 3; ++b)
#pragma unroll
            for (int i = 0; i < 2; ++i) v[b][i] = __builtin_nontemporal_load((const u32x4*)(gp + b * 1024 + i * 512));
#pragma unroll
        for (int i = 0; i < 2; ++i) {
            u32x4 o;
#pragma unroll
            for (int j = 0; j < 4; ++j) o[j] = pk_bf16(lo_f(v[0][i][j]) + lo_f(v[1][i][j]) + lo_f(v[2][i][j]), hi_f(v[0][i][j]) + hi_f(v[1][i][j]) + hi_f(v[2][i][j]));
            *(u32x4*)(M2 + (size_t)r * 1024 + i * 512 + lane * 8) = o;
        }
    }
}

#define XB_TMO      128
#define XB_XCNT(j)  (256  + 64 * (j))
#define XB_XSUB(j)  (1280 + 64 * (j))
#define XB_XGEN(j)  (2304 + 64 * (j))
#define XB_TOP      3328
#define XB_TOPGEN   3392
#define XCD_BAR_WORDS 3456
#define XB_SPIN_CAP (1u << 18)
DI unsigned xb_ld(unsigned* p)              { return __hip_atomic_load(p, __ATOMIC_RELAXED, __HIP_MEMORY_SCOPE_AGENT); }
DI unsigned xb_add(unsigned* p, unsigned v) { return __hip_atomic_fetch_add(p, v, __ATOMIC_RELAXED, __HIP_MEMORY_SCOPE_AGENT); }
DI unsigned xb_xcc_id() { return (unsigned)__builtin_amdgcn_s_getreg((3 << 11) | 20) & 0xFu; }
#define XB_SPIN(cond, bar) do { unsigned _sp = 0; while (cond) { __builtin_amdgcn_s_sleep(1); \
    if ((++_sp & 255u) == 0u) { if (xb_ld(&(bar)[XB_TMO])) break; if (_sp > XB_SPIN_CAP) { atomicAdd(&(bar)[XB_TMO], 1u); break; } } } } while (0)
struct XcdBarrier { unsigned* bar; unsigned x; volatile LAS unsigned* st; };
DI XcdBarrier xcd_barrier_post(unsigned* bar, volatile LAS unsigned* st) {
    XcdBarrier b; b.bar = bar; b.x = xb_xcc_id(); b.st = st;
    if (threadIdx.x == 0) (void)xb_add(&bar[XB_XCNT(b.x)], 1u);
    return b;
}
DI void xcd_barrier_complete(unsigned* bar, unsigned x, unsigned& nloc, unsigned& nx) {
    const unsigned G = gridDim.x * gridDim.y * gridDim.z;
    unsigned sum, cnt, mine, sp = 0u;
    for (;;) {
        sum = 0u; cnt = 0u; mine = 0u;
#pragma unroll
        for (unsigned j = 0; j < 16; ++j) { const unsigned c = xb_ld(&bar[XB_XCNT(j)]); sum += c; cnt += (c > 0u) ? 1u : 0u; mine = (j == x) ? c : mine; }
        if (sum == G) break;
        __builtin_amdgcn_s_sleep(1);
        if ((++sp & 255u) == 0u) { if (xb_ld(&bar[XB_TMO])) break; if (sp > XB_SPIN_CAP) { atomicAdd(&bar[XB_TMO], 1u); break; } }
    }
    nloc = mine > 0u ? mine : 1u; nx = cnt > 0u ? cnt : 1u;
}
DI void xcd_barrier(const XcdBarrier& b) {
    asm volatile("s_waitcnt vmcnt(0)" ::: "memory");
    __syncthreads();
    if (threadIdx.x == 0) {
        unsigned* bar = b.bar; asm volatile("" : "+s"(bar));
        __builtin_amdgcn_s_waitcnt(0);
        unsigned nloc = b.st[0], nx = b.st[1];
        if (nloc == 0u) { xcd_barrier_complete(bar, b.x, nloc, nx); b.st[0] = nloc; b.st[1] = nx; }
        const unsigned old = xb_add(&bar[XB_XSUB(b.x)], 1u);
        const unsigned gen = old / nloc;
        if (old + 1u == (gen + 1u) * nloc) {
            __builtin_amdgcn_fence(__ATOMIC_RELEASE, "agent");
            asm volatile("s_waitcnt vmcnt(0)" ::: "memory");
            const unsigned og = xb_add(&bar[XB_TOP], 1u);
            const unsigned tg = og / nx;
            if (og + 1u == (tg + 1u) * nx) xb_add(&bar[XB_TOPGEN], 1u);
            else XB_SPIN(xb_ld(&bar[XB_TOPGEN]) == tg, bar);
            __builtin_amdgcn_fence(__ATOMIC_ACQUIRE, "agent");
            xb_add(&bar[XB_XGEN(b.x)], 1u);
            asm volatile("s_waitcnt vmcnt(0)" ::: "memory");
        } else {
            XB_SPIN(xb_ld(&bar[XB_XGEN(b.x)]) == gen, bar);
            __builtin_amdgcn_fence(__ATOMIC_ACQUIRE, "agent");
            asm volatile("s_waitcnt vmcnt(0)" ::: "memory");
        }
    }
    __syncthreads();
}

constexpr int NS = 12;
constexpr int S_WIN = 0, S_MIX = 1, S_SCAN = 2, S_GLA3 = 3, S_MERGE = 4, S_SUM = 5, S_WO = 6, S_ROWF = 7, S_UP = 8, S_FIX = 9, S_DOWN = 10, S_ROWI = 11;
constexpr int NSTEPS = 2 + DEPTH * NS;


__global__ void __launch_bounds__(NTHR, 2) mk_fwd(Params p) {
    extern __shared__ __attribute__((aligned(16))) unsigned char lds[];
    cg::grid_group grid = cg::this_grid();
    const int ph_lo = p.ph_lo, ph_hi = p.ph_hi;
    volatile LAS unsigned* xst = (volatile LAS unsigned*)((LAS unsigned char*)lds + 131072);
    if (threadIdx.x == 0) { xst[0] = 0u; xst[1] = 0u; }
    __syncthreads();
    const XcdBarrier xbar = xcd_barrier_post((unsigned*)((unsigned char*)PIN(26) + WS_BAR), xst);
    if (ph_lo == 0 && blockIdx.x == gridDim.x - 1) phase_rope((unsigned char*)PIN(26));
#pragma unroll 1
    for (int step = ph_lo; step < ph_hi; ++step) {
        unsigned char* ws = (unsigned char*)PIN(26);
        asm volatile("" : "+s"(ws));
        bool need_sync = true;
        const float* modt = (const float*)(ws + WS_MOD);
        bf16_t* H = (bf16_t*)(ws + WS_H);
        bf16_t* M2 = (bf16_t*)(ws + WS_M2);
        bf16_t* P = (bf16_t*)(ws + WS_P);
        const int l = step < 2 ? 0 : (step - 2) / NS, s = step < 2 ? -1 : (step - 2) % NS;
        const bool last = (l == DEPTH - 1);
        const int Mr = last ? ML : MT;
        const float* modl = modt + (size_t)l * 9 * 6144;
        const bool is_gemm = (s == S_WIN) || (s == S_MERGE) || (s == S_WO) || (s == S_UP) || (s == S_DOWN);
        if (is_gemm) {
            const bf16_t* gA; const bf16_t* gB; int gM, gN, gK, glda = 1024, gldb = 1024, gasplit = 1 << 30, gaoff2 = 0;
            pg8::EpiU E{0, 0, ws};
            if (s == S_WIN) { gA = H; gB = (const bf16_t*)(ws + WS_WIN); gM = MT; gN = IN_PAD; gK = 1024; E.mode = 0; }
            else if (s == S_MERGE) {
                gA = H; gB = (const bf16_t*)(ws + WS_WBR); gldb = 512; gM = Mr; gN = 3072; gK = 512; gasplit = 4; gaoff2 = 1024; E.mode = 2; }
            else if (s == S_WO) { gA = M2; gB = (const bf16_t*)(ws + WS_WO); gM = Mr; gN = 1024; gK = 1024; E.mode = 1; E.aux = 0; }
            else if (s == S_UP) { gA = H; gB = (const bf16_t*)(ws + WS_WUP); gM = Mr; gN = UPN; gK = 1024; E.mode = 3; E.aux = l; }
            else { gA = (const bf16_t*)(ws + WS_P + PO_ACT); glda = DFF; gB = (const bf16_t*)(ws + WS_WDN); gldb = DFF; gM = Mr; gN = 1024; gK = DFF; E.mode = 1; E.aux = 1; }
            EN_GEMM(run_gemm(lds, gA, glda, gB, gldb, gM, gN, gK, E, gasplit, gaoff2);)
            if (s == S_WO && !last) { EN_CVT(phase_convert_weights(ws, l + 1, lds, 0, T0, 32);) }
            else if (s == S_DOWN && !last) { EN_CVT(phase_convert_weights(ws, l + 1, lds, T0, T5, 32);) }
            else if (s == S_MERGE && l > 0) { EN_CVT(phase_convert_weights(ws, l, lds, T5, T6, last ? 0 : 96);) }
#ifdef PROBE_GEMM_S
            if (s == PROBE_GEMM_S) { run_gemm(lds, gA, glda, gB, gldb, gM, gN, gK, E, gasplit, gaoff2); }
#endif
        } else if (step == 0) {
            EN_ADA(phase_ada(PIN(1), PIN(3), PIN(4), PIN(5), ws, lds); __syncthreads();)
#ifdef PROBE_ADA2
            phase_ada(PIN(1), PIN(3), PIN(4), PIN(5), ws, lds); __syncthreads();
#endif
            EN_CVT(phase_convert_weights(ws, 0, lds, 0, T6, 0);)
        } else if (step == 1) {
            EN_ROW(phase_rowpass(ws, MT, PIN(0), PIN(2), nullptr, nullptr, nullptr, false, true, modt, 1, 0, PIN(6));)
        } else if (s == S_MIX) {
#ifdef PROBE_MIX2
          for (int rep = 0; rep < 2; ++rep) {
#endif
            const int nA = NB * 32 * 4, nC = last ? 0 : NB * 2 * 4, nG = NCH * 4, nP = last ? 512 : NCH;
            const int ntot = nA + nC + nG + nP;
            const float* rope = (const float*)(ws + WS_ROPE);
#pragma unroll 1
            for (int it = obid(); it < ntot; it += ogrid()) {
                if (it < nA + nC) {
                    const bool isc = it >= nA; const int j = isc ? it - nA : it;
                    const int h = j & 3, blk = isc ? ((j >> 2) & 1) : ((j >> 2) & 31), b = isc ? (j >> 3) : (j >> 7);
                    EN_ATT(attn_item(P, H, PIN(11) + l * 8, rope, lds, isc, b, blk, h);)
#ifdef PROBE_ATT2
                    attn_item(P, H, PIN(11) + l * 8, rope, lds, isc, b, blk, h);
#endif
                }
                else if (it < nA + nC + nG) { const int j = it - nA - nC; EN_GLA1(gla_pass1_item(ws, PIN(14) + (size_t)l * 4096, PIN(15) + (size_t)l * 256, lds, j >> 2, j & 3);)
#ifdef PROBE_GLA12
                    gla_pass1_item(ws, PIN(14) + (size_t)l * 4096, PIN(15) + (size_t)l * 256, lds, j >> 2, j & 3);
#endif
                }
                else { const int j = it - nA - nC - nG; EN_POOL(pool_item(P, H, PIN(12) + (size_t)l * 4 * 4096, PIN(13) + (size_t)l * 256, lds, j);)
#ifdef PROBE_POOL2
                    pool_item(P, H, PIN(12) + (size_t)l * 4 * 4096, PIN(13) + (size_t)l * 256, lds, j);
#endif
                }
            }
            __syncthreads();
#ifdef PROBE_MIX2
          }
#endif
        }
        else if (s == S_SCAN) { EN_SCAN(phase_gla_scan(ws);) }
        else if (s == S_GLA3) {
            const int nch = last ? 512 : NCH;
#pragma unroll 1
            for (int it = obid(); it < nch * 4; it += ogrid()) { EN_GLA3(gla_pass3_item(ws, PIN(14) + (size_t)l * 4096, PIN(15) + (size_t)l * 256, PIN(16) + (size_t)l * 256, lds, it >> 2, it & 3);)
#ifdef PROBE_GLA32
                    gla_pass3_item(ws, PIN(14) + (size_t)l * 4096, PIN(15) + (size_t)l * 256, PIN(16) + (size_t)l * 256, lds, it >> 2, it & 3);
#endif
                }
            __syncthreads();
        }
        else if (s == S_SUM) { phase_merge_sum(P, M2, Mr); }
        else if (s == S_ROWF) {
#ifdef PROBE_ROW2
            phase_rowpass(ws, Mr, l == 0 ? PIN(0) : PIN(25), l == 0 ? PIN(2) : (const float*)(ws + WS_CTXRES), (const float*)(ws + WS_P), modl + 2 * 1024, PIN(7) + l * 1024,
                                 false, true, modl, 4, 3, PIN(8) + l * 1024);
#endif
            EN_ROW(phase_rowpass(ws, Mr, l == 0 ? PIN(0) : PIN(25), l == 0 ? PIN(2) : (const float*)(ws + WS_CTXRES), (const float*)(ws + WS_P), modl + 2 * 1024, PIN(7) + l * 1024,
                                 true, true, modl, 4, 3, PIN(8) + l * 1024);)
        }
        else if (s == S_FIX) {
            EN_CONV(phase_conv_fixup((const float*)(ws + WS_P + PO_UCH), (bf16_t*)(ws + WS_P + PO_ACT), PIN(22) + (size_t)l * 3 * UPN, PIN(23) + (size_t)l * UPN);)
        }
        else {
            EN_ROW(phase_rowpass(ws, Mr, PIN(25), (const float*)(ws + WS_CTXRES), (const float*)(ws + WS_P + PO_Y2), modl + 5 * 1024, PIN(9) + l * 1024,
                          true, !last, modl + 9 * 6144, 1, 0, PIN(6) + (last ? 0 : (l + 1) * 1024));)
        }
        if (need_sync && step + 1 < ph_hi) {
            if (ph_lo < 0) grid.sync();
            xcd_barrier(xbar);
        }
#ifdef PROBE_SYNC2
        xcd_barrier(xbar); xcd_barrier(xbar);
#endif
    }
}

extern "C" void kernel_launch(void* const* d_in, const int* in_sizes, int n_in, void* d_out, int out_size, void* d_ws, size_t ws_size, hipStream_t stream) {
    static int grid = 0;
    if (!grid) {
        int dev = 0, cus = 0, per_cu = 0;
        (void)hipGetDevice(&dev);
        (void)hipDeviceGetAttribute(&cus, hipDeviceAttributeMultiprocessorCount, dev);
        (void)hipFuncSetAttribute((const void*)mk_fwd, hipFuncAttributeMaxDynamicSharedMemorySize, LDS_BYTES);
        (void)hipOccupancyMaxActiveBlocksPerMultiprocessor(&per_cu, (const void*)mk_fwd, NTHR, LDS_BYTES);
        if (per_cu < 1) per_cu = 1;
        grid = cus * per_cu;
        if (ws_size < WS_END || n_in != 25) { fprintf(stderr, "kernel_launch: ws %zu < %zu or n_in %d\n", ws_size, (size_t)WS_END, n_in); }
    }
    (void)hipMemsetAsync((unsigned char*)d_ws + WS_BAR, 0, 16384, stream);
    Params p{};
    for (int i = 0; i < 25; ++i) p.in[i] = (const float*)d_in[i];
    p.out = (float*)d_out; p.ws = (unsigned char*)d_ws; p.ph_lo = 0; p.ph_hi = NSTEPS;
    void* args[] = {&p};
    hipError_t e = hipLaunchCooperativeKernel((const void*)mk_fwd, dim3(grid), dim3(NTHR), args, LDS_BYTES, stream);
    if (e != hipSuccess) fprintf(stderr, "cooperative launch failed: %s (grid %d)\n", hipGetErrorString(e), grid);
}
```
